# Optimizing an MI355X kernel written in HIP

```python
import jax, jax.numpy as jnp
from jax import lax
import numpy as np


D_MODEL = 1024
BATCH = 4
SEQ = 8192
DEPTH = 2

GRID_W = 64
CTX_LEN = 256
N_EVEN = (DEPTH + 1) // 2
N_ODD = DEPTH // 2
RMS_EPS = 1e-6

POOL_WIDTH = D_MODEL // 2
POOL_WINDOWS = (2, 4, 8, 16)
POOL_GROUP = POOL_WIDTH // len(POOL_WINDOWS)
HG_WIDTH = D_MODEL // 2
HG_HEAD_DIM = 128
HG_HEADS = HG_WIDTH // HG_HEAD_DIM
HG_CHUNK = 64
AB_IN = POOL_WIDTH + 5 * HG_WIDTH
AB_MIX = POOL_WIDTH + HG_WIDTH
ATT_HEAD_DIM = 128
ATT_HEADS = D_MODEL // ATT_HEAD_DIM
ATT_KV_HEADS = 2
ATT_GROUP = ATT_HEADS // ATT_KV_HEADS
ATT_IN = (ATT_HEADS + 2 * ATT_KV_HEADS) * ATT_HEAD_DIM
Q_BLOCK = 128
ROPE_THETA = 10000.0
FFN_HIDDEN = ((8 * D_MODEL + 3 * 256 - 1) // (3 * 256)) * 256

kernel_name = "hybrid_pool_hgrn2_gqa_diffusion_trunk"

F32 = jnp.float32


def rmsnorm(x, g):
    xf = x.astype(F32)
    y = xf * lax.rsqrt(jnp.mean(xf * xf, axis=-1, keepdims=True) + RMS_EPS)
    return (y * g.astype(F32)).astype(x.dtype)


def flip(a):
    return a[:, ::-1]


def swiglu(h, w_in, w_out):
    a, b = jnp.split(h @ w_in, 2, axis=-1)
    return (jax.nn.silu(a) * b) @ w_out


def grid_rope(x):
    L = x.shape[1]
    rows = L // GRID_W
    row = jnp.repeat(jnp.arange(rows, dtype=F32), GRID_W)
    col = jnp.tile(jnp.arange(GRID_W, dtype=F32), rows)
    n_freq = ATT_HEAD_DIM // 4
    inv = ROPE_THETA ** (-jnp.arange(n_freq, dtype=F32) / n_freq)

    def rot(xa, pos):
        ang = pos[:, None] * inv[None, :]
        cos = jnp.cos(ang)[:, None, :]
        sin = jnp.sin(ang)[:, None, :]
        x1, x2 = jnp.split(xa, 2, axis=-1)
        return jnp.concatenate([x1 * cos - x2 * sin, x2 * cos + x1 * sin], axis=-1)

    xf = x.astype(F32)
    half = ATT_HEAD_DIM // 2
    return jnp.concatenate([rot(xf[..., :half], row), rot(xf[..., half:], col)], axis=-1).astype(x.dtype)


def multiscale_pool(u, pool_w, pool_scale):
    Bn, Ln, _ = u.shape
    cs = jnp.pad(jnp.cumsum(u.astype(F32), axis=1), ((0, 0), (1, 0), (0, 0)))
    t = jnp.arange(Ln)
    groups = []
    for gi, w in enumerate(POOL_WINDOWS):
        lo = jnp.clip(t - w // 2, 0, Ln)
        hi = jnp.clip(t - w // 2 + w, 0, Ln)
        sl = slice(gi * POOL_GROUP, (gi + 1) * POOL_GROUP)
        csg = cs[..., sl]
        mean = (csg[:, hi] - csg[:, lo]) / (hi - lo).astype(F32)[None, :, None]
        groups.append(mean - u[..., sl].astype(F32))
    y = jnp.stack(groups, axis=2).astype(u.dtype)
    y = jnp.einsum('blgc,gcd->blgd', y, pool_w).reshape(Bn, Ln, POOL_WIDTH)
    return y * pool_scale


def hgrn_scan(q, k, v, logf, s0):
    Bn, Ln, H, _ = q.shape
    dv = v.shape[-1]
    n = Ln // HG_CHUNK

    def chunks(a):
        return jnp.moveaxis(a.reshape(Bn, n, HG_CHUNK, H, a.shape[-1]), 1, 0)

    causal = jnp.tril(jnp.ones((HG_CHUNK, HG_CHUNK), dtype=bool))[None, :, :, None, None]

    def step(S, inp):
        qc, kc, vc, gc = inp
        b = jnp.cumsum(gc, axis=1)
        dec = jnp.exp(jnp.where(causal, b[:, :, None] - b[:, None, :], -jnp.inf))
        a = jnp.einsum('bthd,btshd->btsh', qc, dec * kc[:, None])
        o = jnp.einsum('btsh,bshe->bthe', a, vc) + jnp.einsum('bthd,bhde->bthe', qc * jnp.exp(b), S)
        b_last = b[:, -1]
        S = jnp.exp(b_last)[..., None] * S + jnp.einsum('bshd,bshe->bhde', kc * jnp.exp(b_last[:, None] - b), vc)
        return S, o

    s_fin, o = lax.scan(step, s0, (chunks(q), chunks(k), chunks(v), chunks(logf)))
    return jnp.moveaxis(o, 0, 1).reshape(Bn, Ln, H, dv), s_fin


def pool_hgrn_mixer(h_lat, h_ctx, w_in, w_out, pool_w, pool_scale, lb, onorm_g, need_ctx):
    def project(h):
        z = h @ w_in
        Bn, Ln = z.shape[:2]
        u = z[..., :POOL_WIDTH]
        q, zf, zb, v, g = jnp.split(z[..., POOL_WIDTH:], 5, axis=-1)
        heads = lambda a: a.reshape(Bn, Ln, HG_HEADS, HG_HEAD_DIM).astype(F32)
        return u, heads(jax.nn.silu(q)), heads(zf), heads(zb), heads(v), g

    def gate(z, lb_dir):
        f = lb_dir + (1.0 - lb_dir) * jax.nn.sigmoid(z)
        return 1.0 - f, jnp.log(f)

    lb_f = lb[0].reshape(HG_HEADS, HG_HEAD_DIM)
    lb_b = lb[1].reshape(HG_HEADS, HG_HEAD_DIM)
    u_c, q_c, zf_c, zb_c, v_c, g_c = project(h_ctx)
    u_l, q_l, zf_l, zb_l, v_l, g_l = project(h_lat)
    k_cf, lf_cf = gate(zf_c, lb_f)
    k_cb, lf_cb = gate(zb_c, lb_b)
    k_lf, lf_lf = gate(zf_l, lb_f)
    k_lb, lf_lb = gate(zb_l, lb_b)

    s0 = jnp.zeros((h_ctx.shape[0], HG_HEADS, HG_HEAD_DIM, HG_HEAD_DIM), F32)
    o_cf, s_f = hgrn_scan(q_c, k_cf, v_c, lf_cf, s0)
    o_cb, s_b = hgrn_scan(flip(q_c), flip(k_cb), flip(v_c), flip(lf_cb), s0)
    o_lf, _ = hgrn_scan(q_l, k_lf, v_l, lf_lf, s_f)
    o_lb, _ = hgrn_scan(flip(q_l), flip(k_lb), flip(v_l), flip(lf_lb), s_b)

    def readout(o_sum, g, u):
        Bn, Ln = g.shape[:2]
        o = rmsnorm(o_sum, onorm_g).reshape(Bn, Ln, HG_WIDTH).astype(g.dtype) * jax.nn.silu(g)
        return jnp.concatenate([multiscale_pool(u, pool_w, pool_scale), o], axis=-1) @ w_out

    y_lat = readout(o_lf + flip(o_lb), g_l, u_l)
    y_ctx = readout(o_cf + flip(o_cb), g_c, u_c) if need_ctx else None
    return y_lat, y_ctx


def gqa_mixer(h_lat, h_ctx, w_in, w_out, qn_g, kn_g, need_ctx):
    dh = ATT_HEAD_DIM

    def project(h):
        z = h @ w_in
        Bn, Ln = z.shape[:2]
        q = z[..., :ATT_HEADS * dh].reshape(Bn, Ln, ATT_HEADS, dh)
        k = z[..., ATT_HEADS * dh:(ATT_HEADS + ATT_KV_HEADS) * dh].reshape(Bn, Ln, ATT_KV_HEADS, dh)
        v = z[..., (ATT_HEADS + ATT_KV_HEADS) * dh:].reshape(Bn, Ln, ATT_KV_HEADS, dh)
        return rmsnorm(q, qn_g), rmsnorm(k, kn_g), v

    Bn, L, _ = h_lat.shape
    Lc = h_ctx.shape[1]
    q_l, k_l, v_l = project(h_lat)
    q_c, k_c, v_c = project(h_ctx)
    q_l = grid_rope(q_l)
    k_l = grid_rope(k_l)
    k_all = jnp.concatenate([k_l, k_c], axis=1)
    v_all = jnp.concatenate([v_l, v_c], axis=1)
    scale = dh ** -0.5

    def attend(qb, k, v):
        s = jnp.einsum('bqhgd,bkhd->bhgqk', qb, k, preferred_element_type=F32) * scale
        p = jax.nn.softmax(s, axis=-1).astype(v.dtype)
        return jnp.einsum('bhgqk,bkhd->bqhgd', p, v)

    q_blocks = jnp.moveaxis(q_l.reshape(Bn, L // Q_BLOCK, Q_BLOCK, ATT_KV_HEADS, ATT_GROUP, dh), 1, 0)
    o = lax.map(lambda qb: attend(qb, k_all, v_all), q_blocks)
    y_lat = jnp.moveaxis(o, 0, 1).reshape(Bn, L, ATT_HEADS * dh) @ w_out
    y_ctx = None
    if need_ctx:
        o_c = attend(q_c.reshape(Bn, Lc, ATT_KV_HEADS, ATT_GROUP, dh), k_c, v_c)
        y_ctx = o_c.reshape(Bn, Lc, ATT_HEADS * dh) @ w_out
    return y_lat, y_ctx


def setup_inputs(seed: int = 0) -> dict:
    key = jax.random.key(seed)
    ks = jax.random.split(key, 20)
    D = D_MODEL
    nrm = lambda k, shape, s: jax.random.normal(k, shape, F32) * s
    return {
        "x": nrm(ks[0], (BATCH, SEQ, D), 1.0),
        "c": nrm(ks[1], (BATCH, D), 1.0),
        "ctx": nrm(ks[2], (BATCH, CTX_LEN, D), 1.0),
        "c_ctx": nrm(ks[3], (D,), 1.0),
        "ada_w": nrm(ks[4], (DEPTH, D, 6 * D), 0.5 * D ** -0.5),
        "ada_b": nrm(ks[5], (DEPTH, 6 * D), 0.02),
        "norm_g": 1.0 + nrm(ks[6], (DEPTH, 4, D), 0.02),
        "ab_w_in": nrm(ks[7], (N_EVEN, D, AB_IN), D ** -0.5),
        "ab_w_out": nrm(ks[8], (N_EVEN, AB_MIX, D), AB_MIX ** -0.5),
        "pool_w": nrm(ks[9], (N_EVEN, len(POOL_WINDOWS), POOL_GROUP, POOL_GROUP), POOL_GROUP ** -0.5),
        "pool_scale": 1.0 + nrm(ks[10], (N_EVEN, POOL_WIDTH), 0.1),
        "hg_lower": nrm(ks[11], (N_EVEN + 1, 2, HG_WIDTH), 0.1),
        "hg_onorm_g": 1.0 + nrm(ks[12], (N_EVEN, HG_HEAD_DIM), 0.02),
        "att_w_in": nrm(ks[13], (N_ODD, D, ATT_IN), D ** -0.5),
        "att_w_out": nrm(ks[14], (N_ODD, ATT_HEADS * ATT_HEAD_DIM, D), (ATT_HEADS * ATT_HEAD_DIM) ** -0.5),
        "att_qnorm_g": 1.0 + nrm(ks[15], (N_ODD, ATT_HEAD_DIM), 0.02),
        "att_knorm_g": 1.0 + nrm(ks[16], (N_ODD, ATT_HEAD_DIM), 0.02),
        "ffn_w_in": nrm(ks[17], (DEPTH, D, 2 * FFN_HIDDEN), D ** -0.5),
        "ffn_w_out": nrm(ks[18], (DEPTH, FFN_HIDDEN, D), FFN_HIDDEN ** -0.5),
    }


def reference(x, c, ctx, c_ctx, ada_w, ada_b, norm_g, ab_w_in, ab_w_out, pool_w, pool_scale,
              hg_lower, hg_onorm_g, att_w_in, att_w_out, att_qnorm_g, att_knorm_g, ffn_w_in, ffn_w_out):
    lb_all = jnp.cumsum(jax.nn.softmax(hg_lower.astype(F32), axis=0), axis=0)
    ctx_s = ctx
    for l in range(DEPTH):
        j = l // 2
        need_ctx = l < DEPTH - 1
        m_lat = (jax.nn.silu(c) @ ada_w[l] + ada_b[l])[:, None]
        m_ctx = jax.nn.silu(c_ctx) @ ada_w[l] + ada_b[l]
        sh1, sc1, g1, sh2, sc2, g2 = jnp.split(m_lat, 6, axis=-1)
        csh1, csc1, cg1, csh2, csc2, cg2 = jnp.split(m_ctx, 6, axis=-1)

        h_lat = rmsnorm(x, norm_g[l, 0]) * (1.0 + sc1) + sh1
        h_ctx = rmsnorm(ctx_s, norm_g[l, 0]) * (1.0 + csc1) + csh1
        if l % 2 == 0:
            y_lat, y_ctx = pool_hgrn_mixer(h_lat, h_ctx, ab_w_in[j], ab_w_out[j], pool_w[j], pool_scale[j],
                                           lb_all[j], hg_onorm_g[j], need_ctx)
        else:
            y_lat, y_ctx = gqa_mixer(h_lat, h_ctx, att_w_in[j], att_w_out[j], att_qnorm_g[j], att_knorm_g[j],
                                     need_ctx)
        x = x + g1 * rmsnorm(y_lat, norm_g[l, 1])
        f_lat = swiglu(rmsnorm(x, norm_g[l, 2]) * (1.0 + sc2) + sh2, ffn_w_in[l], ffn_w_out[l])
        x = x + g2 * rmsnorm(f_lat, norm_g[l, 3])

        if need_ctx:
            ctx_s = ctx_s + cg1 * rmsnorm(y_ctx, norm_g[l, 1])
            f_ctx = swiglu(rmsnorm(ctx_s, norm_g[l, 2]) * (1.0 + csc2) + csh2, ffn_w_in[l], ffn_w_out[l])
            ctx_s = ctx_s + cg2 * rmsnorm(f_ctx, norm_g[l, 3])
    return x
```

```cpp
#include <hip/hip_runtime.h>
#include <hip/hip_cooperative_groups.h>
#include <hip/hip_bf16.h>
#include <cstdio>
#include <cstdint>
#include <cmath>
namespace cg = cooperative_groups;
namespace pg8 {
#define PG8_LAS __attribute__((address_space(3)))
typedef unsigned short bf16_t;
typedef short bf16x8 __attribute__((ext_vector_type(8)));
typedef float f32x4 __attribute__((ext_vector_type(4)));
typedef unsigned u32x4 __attribute__((ext_vector_type(4)));
constexpr int BM = 256, BK = 64, HALF = 128, HTB = HALF * BK * 2  , STAGE_BYTES = 8 * HTB, NXCD = 8, WGM = 8;

__host__ __device__ __forceinline__ int lds_byte(int r, int c) { const int st = (r >> 4) * 2 + (c >> 5), rr = r & 15, cc = c & 31, ob = rr * 64 + cc * 2; return st * 1024 + (ob ^ (((ob >> 9) & 1) << 5)); }
__host__ __device__ __forceinline__ void stage_rc(int b, int& R, int& C) { const int st = b / 1024, sb = b % 1024, swz = sb ^ (((sb >> 9) & 1) << 5); R = (st >> 1) * 16 + swz / 64; C = (st & 1) * 32 + (swz % 64) / 2; }
__host__ __device__ __forceinline__ int perm32(int rho) { const int n = rho >> 4, i = rho & 15; return 8 * (i >> 2) + 4 * n + (i & 3); }

struct Unit { int pm, pn; };
struct Gemm { const bf16_t* A; const bf16_t* Bt; int M, N, K; };

struct StaticOrder {
    int nM, nN, nwg, G, c;
    __host__ __device__ void init(int M, int N, int G_, int c_) { nM = M / BM; nN = N / BM; nwg = nM * nN; G = G_; c = c_; }
    __host__ __device__ bool next(int i, Unit& u) const {
        const long L = (long)i * G + c; if (L >= nwg) return false;
        int wgid = (int)L; { const int q = nwg / NXCD, r = nwg % NXCD, xcd = wgid % NXCD, off = wgid / NXCD; wgid = (xcd < r ? xcd * (q + 1) : r * (q + 1) + (xcd - r) * q) + off; }
        const int nig = WGM * nN, gid = wgid / nig, fm = gid * WGM, gsz = (nM - fm) < WGM ? (nM - fm) : WGM;
        u.pm = fm + ((wgid % nig) % gsz); u.pn = (wgid % nig) / gsz; return true;
    }
    __device__ __forceinline__ void a_ready(const Unit&) const {}
    __device__ __forceinline__ void done(const Unit&) const {}
};

__device__ __forceinline__ unsigned cvt_pk_bf16(float lo, float hi) { unsigned r; asm volatile("v_cvt_pk_bf16_f32 %0, %1, %2" : "=v"(r) : "v"(lo), "v"(hi)); return r; }
template <class Epi, class Sched, bool ALIGN_EPI = false, bool SP2 = false>
__device__ __forceinline__ void gemm_phase(PG8_LAS unsigned char* lds, const Gemm g, const Sched& S, const Epi& E) {
    const int tid = threadIdx.x, wid = __builtin_amdgcn_readfirstlane(tid >> 6), lane = tid & 63, wr = wid >> 2, wc = wid & 3, fr = lane & 15, fq = lane >> 4;
    const int K = g.K, nt = K / BK;
    unsigned voffA[2], voffB[2];
#pragma unroll
    for (int i = 0; i < 2; ++i) { int R, C; stage_rc(tid * 16 + i * 8192, R, C); const int Rb = Epi::PERM ? ((R & ~31) + perm32(R & 31)) : R;
        voffA[i] = (unsigned)(R * K + C) * 2u; voffB[i] = (unsigned)(Rb * K + C) * 2u; }
    const size_t kstep = (size_t)(BK * 2);
    const size_t hstep = (size_t)HALF * K * 2;
    const size_t tstep = 2 * hstep;
    const unsigned ldsw = (unsigned)wid * 1024u;
    const int aoff = lds_byte(wr * 64 + fr, fq * 8), boff = lds_byte(wc * 32 + fr, fq * 8);
#define PG8_SA(b, h) (((b) * 2 + (h)) * HTB)
#define PG8_SB(b, h) ((4 + (b) * 2 + (h)) * HTB)
#define PG8_STAGE(bufoff, gbase, voff) do { _Pragma("unroll") for (int _i = 0; _i < 2; ++_i) \
        __builtin_amdgcn_global_load_lds((const unsigned*)((const char*)(gbase) + (voff)[_i]), (PG8_LAS unsigned*)(lds + (bufoff) + ldsw + _i * 8192), 16, 0, 0); } while (0)
#define PG8_LDA(dst, b, h) do { _Pragma("unroll") for (int m = 0; m < 4; ++m) _Pragma("unroll") for (int k = 0; k < 2; ++k) dst[m][k] = *(const PG8_LAS bf16x8*)(lds + PG8_SA(b, h) + aoff + m * 2048 + k * 1024); } while (0)
#define PG8_LDB(dst, b, h) do { _Pragma("unroll") for (int n = 0; n < 2; ++n) _Pragma("unroll") for (int k = 0; k < 2; ++k) dst[n][k] = *(const PG8_LAS bf16x8*)(lds + PG8_SB(b, h) + boff + n * 2048 + k * 1024); } while (0)
#define PG8_MMA(ai, bj, At, Bt) do { __builtin_amdgcn_s_setprio(1); _Pragma("unroll") for (int m = 0; m < 4; ++m) _Pragma("unroll") for (int n = 0; n < 2; ++n) _Pragma("unroll") for (int k = 0; k < 2; ++k) \
        acc[ai][bj][m][n] = __builtin_amdgcn_mfma_f32_16x16x32_bf16(Bt[n][k], At[m][k], acc[ai][bj][m][n], 0, 0, 0); __builtin_amdgcn_s_setprio(0); } while (0)
#define PG8_WAIT_V(n) asm volatile("s_waitcnt vmcnt(" #n ")" ::: "memory")
#define PG8_WAIT_L(n) asm volatile("s_waitcnt lgkmcnt(" #n ")" ::: "memory")
#define PG8_BAR __builtin_amdgcn_s_barrier()
#define PG8_SCHED __builtin_amdgcn_sched_barrier(0)
    Unit cur, nxt; int ui = 0;
    if (!S.next(0, cur)) return;
    f32x4 acc[2][2][4][2];
#pragma unroll
    for (int a = 0; a < 2; ++a)
#pragma unroll
        for (int b = 0; b < 2; ++b)
#pragma unroll
            for (int m = 0; m < 4; ++m)
#pragma unroll
                for (int n = 0; n < 2; ++n) acc[a][b][m][n] = (f32x4){0.f, 0.f, 0.f, 0.f};
    bf16x8 At[4][2], B0[2][2], B1[2][2];
    const char* cA = (const char*)g.A + (size_t)cur.pm * tstep; const char* cB = (const char*)g.Bt + (size_t)cur.pn * tstep;
    S.a_ready(cur);
    if constexpr (SP2) {
        PG8_STAGE(PG8_SB(0, 0), cB, voffB); PG8_STAGE(PG8_SB(0, 1), cB + hstep, voffB); PG8_STAGE(PG8_SA(0, 0), cA, voffA); PG8_STAGE(PG8_SA(0, 1), cA + hstep, voffA);
        if (wr == 1) PG8_BAR;
        PG8_WAIT_V(2); PG8_BAR;
        PG8_STAGE(PG8_SB(1, 0), cB + kstep, voffB); PG8_STAGE(PG8_SA(1, 0), cA + kstep, voffA); PG8_STAGE(PG8_SB(1, 1), cB + hstep + kstep, voffB);
        PG8_WAIT_V(6); PG8_BAR;
    } else {
        PG8_STAGE(PG8_SB(0, 0), cB, voffB); PG8_STAGE(PG8_SA(0, 0), cA, voffA); PG8_STAGE(PG8_SB(0, 1), cB + hstep, voffB); PG8_STAGE(PG8_SA(0, 1), cA + hstep, voffA);
        if (wr == 1) PG8_BAR;
        PG8_WAIT_V(4); PG8_BAR;
        PG8_STAGE(PG8_SB(1, 0), cB + kstep, voffB); PG8_STAGE(PG8_SA(1, 0), cA + kstep, voffA); PG8_STAGE(PG8_SB(1, 1), cB + hstep + kstep, voffB);
        PG8_WAIT_V(6); PG8_BAR;
    }
    for (;;) {
        const bool has_next = S.next(ui + 1, nxt);
        const char* nA = has_next ? (const char*)g.A + (size_t)nxt.pm * tstep : cA; const char* nB = has_next ? (const char*)g.Bt + (size_t)nxt.pn * tstep : cB;
        for (int t = 0; t < nt; t += 2) {
            const bool last = (t == nt - 2);
            const char* a1 = cA + (size_t)(t + 1) * kstep;
            const char* a2 = last ? nA : cA + (size_t)(t + 2) * kstep; const char* b2 = last ? nB : cB + (size_t)(t + 2) * kstep;
            const char* a3 = a2 + kstep; const char* b3 = b2 + kstep;
            if (last && has_next) S.a_ready(nxt);
            if constexpr (SP2) {
            PG8_LDB(B0, 0, 0); PG8_LDB(B1, 0, 1); PG8_SCHED; PG8_LDA(At, 0, 0); PG8_STAGE(PG8_SA(1, 1), a1 + hstep, voffA);
            PG8_WAIT_V(8); PG8_WAIT_L(0); PG8_BAR; PG8_MMA(0, 0, At, B0); PG8_MMA(0, 1, At, B1); PG8_BAR; PG8_SCHED;
            PG8_LDA(At, 0, 1); PG8_STAGE(PG8_SB(0, 0), b2, voffB); PG8_STAGE(PG8_SB(0, 1), b2 + hstep, voffB); PG8_STAGE(PG8_SA(0, 0), a2, voffA);
            PG8_WAIT_V(8); PG8_WAIT_L(0); PG8_BAR; PG8_MMA(1, 0, At, B0); PG8_MMA(1, 1, At, B1); PG8_BAR; PG8_SCHED;
            PG8_LDB(B0, 1, 0); PG8_LDB(B1, 1, 1); PG8_SCHED; PG8_LDA(At, 1, 0); PG8_STAGE(PG8_SA(0, 1), a2 + hstep, voffA);
            PG8_WAIT_V(8); PG8_WAIT_L(0); PG8_BAR; PG8_MMA(0, 0, At, B0); PG8_MMA(0, 1, At, B1); PG8_BAR; PG8_SCHED;
            PG8_LDA(At, 1, 1); PG8_STAGE(PG8_SB(1, 0), b3, voffB); PG8_STAGE(PG8_SB(1, 1), b3 + hstep, voffB); PG8_STAGE(PG8_SA(1, 0), a3, voffA);
            PG8_WAIT_V(8); PG8_WAIT_L(0); PG8_BAR; PG8_MMA(1, 0, At, B0); PG8_MMA(1, 1, At, B1); PG8_BAR; PG8_SCHED;
            } else {
            PG8_LDB(B0, 0, 0); PG8_SCHED; PG8_LDA(At, 0, 0); PG8_STAGE(PG8_SA(1, 1), a1 + hstep, voffA);
            PG8_WAIT_L(8); PG8_BAR; PG8_WAIT_L(0); PG8_MMA(0, 0, At, B0); PG8_BAR; PG8_SCHED;
            PG8_LDB(B1, 0, 1); PG8_STAGE(PG8_SB(0, 0), b2, voffB);
            PG8_BAR; PG8_WAIT_L(0); PG8_MMA(0, 1, At, B1); PG8_BAR;
            PG8_LDA(At, 0, 1); PG8_STAGE(PG8_SA(0, 0), a2, voffA);
            PG8_BAR; PG8_WAIT_L(0); PG8_MMA(1, 0, At, B0); PG8_BAR; PG8_SCHED;
            PG8_STAGE(PG8_SB(0, 1), b2 + hstep, voffB);
            PG8_WAIT_V(6); PG8_BAR; PG8_MMA(1, 1, At, B1); PG8_BAR;
            PG8_LDB(B0, 1, 0); PG8_SCHED; PG8_LDA(At, 1, 0); PG8_STAGE(PG8_SA(0, 1), a2 + hstep, voffA);
            PG8_WAIT_L(8); PG8_BAR; PG8_WAIT_L(0); PG8_MMA(0, 0, At, B0); PG8_BAR; PG8_SCHED;
            PG8_LDB(B1, 1, 1); PG8_STAGE(PG8_SB(1, 0), b3, voffB);
            PG8_BAR; PG8_WAIT_L(0); PG8_MMA(0, 1, At, B1); PG8_BAR;
            PG8_LDA(At, 1, 1); PG8_STAGE(PG8_SA(1, 0), a3, voffA);
            PG8_BAR; PG8_WAIT_L(0); PG8_MMA(1, 0, At, B0); PG8_BAR; PG8_SCHED;
            PG8_STAGE(PG8_SB(1, 1), b3 + hstep, voffB);
            PG8_WAIT_V(6); PG8_BAR; PG8_MMA(1, 1, At, B1); PG8_BAR;
            }
        }
        if constexpr (ALIGN_EPI) { if (wr == 0) PG8_BAR; }
        if constexpr (!Epi::AFTER_DRAIN) { E(acc, cur, wr, wc, fr, fq); S.done(cur); }
        if (!has_next) break;
#pragma unroll
        for (int a = 0; a < 2; ++a)
#pragma unroll
            for (int b = 0; b < 2; ++b)
#pragma unroll
                for (int m = 0; m < 4; ++m)
#pragma unroll
                    for (int n = 0; n < 2; ++n) acc[a][b][m][n] = (f32x4){0.f, 0.f, 0.f, 0.f};
        cur = nxt; cA = nA; cB = nB; ++ui;
        if constexpr (ALIGN_EPI) { if (wr == 1) PG8_BAR; }
    }
    PG8_WAIT_V(0);
    if constexpr (!ALIGN_EPI) { if (wr == 0) PG8_BAR; }
    PG8_BAR;
    if constexpr (Epi::AFTER_DRAIN) { E.fused(acc, cur, wr, wc, fr, fq, lds, wid, lane); S.done(cur); }
#undef PG8_SA
#undef PG8_SB
#undef PG8_STAGE
#undef PG8_LDA
#undef PG8_LDB
#undef PG8_MMA
#undef PG8_WAIT_V
#undef PG8_WAIT_L
#undef PG8_BAR
#undef PG8_SCHED
}
}
namespace pg8 {
struct EpiStoreBf16 {
    static constexpr bool PERM = true, AFTER_DRAIN = false;
    bf16_t* O; int ldc;
    __device__ __forceinline__ void operator()(const f32x4 (&acc)[2][2][4][2], const Unit& u, int wr, int wc, int fr, int fq) const {
        const int row0 = u.pm * BM + wr * 64 + fr, col0 = u.pn * BM + wc * 32 + 8 * fq;
#pragma unroll
        for (int ai = 0; ai < 2; ++ai)
#pragma unroll
            for (int m = 0; m < 4; ++m) { bf16_t* rowp = O + (size_t)(row0 + ai * HALF + m * 16) * ldc + col0;
#pragma unroll
                for (int bj = 0; bj < 2; ++bj) { const f32x4 v0 = acc[ai][bj][m][0], v1 = acc[ai][bj][m][1];
                    u32x4 w; w.x = cvt_pk_bf16(v0[0], v0[1]); w.y = cvt_pk_bf16(v0[2], v0[3]); w.z = cvt_pk_bf16(v1[0], v1[1]); w.w = cvt_pk_bf16(v1[2], v1[3]);
                    *(u32x4*)(rowp + bj * HALF) = w; } }
    }
};
struct EpiZ {
    static constexpr bool PERM = true, AFTER_DRAIN = false;
    bf16_t* U; bf16_t* ZH; int mrows;
    __device__ __forceinline__ void operator()(const f32x4 (&acc)[2][2][4][2], const Unit& u, int wr, int wc, int fr, int fq) const {
        const int row0 = u.pm * BM + wr * 64 + fr;
#pragma unroll
        for (int bj = 0; bj < 2; ++bj) { const int c = u.pn * BM + bj * HALF + wc * 32 + 8 * fq;
            bf16_t* base; size_t rstride;
            if (c < 512) { base = U + c; rstride = 512; } else { const int cp = c - 512, h = cp / 640, off = cp - h * 640; base = ZH + (size_t)h * mrows * 640 + off; rstride = 640; }
#pragma unroll
            for (int ai = 0; ai < 2; ++ai)
#pragma unroll
                for (int m = 0; m < 4; ++m) { const f32x4 v0 = acc[ai][bj][m][0], v1 = acc[ai][bj][m][1];
                    u32x4 w; w.x = cvt_pk_bf16(v0[0], v0[1]); w.y = cvt_pk_bf16(v0[2], v0[3]); w.z = cvt_pk_bf16(v1[0], v1[1]); w.w = cvt_pk_bf16(v1[2], v1[3]);
                    *(u32x4*)(base + (size_t)(row0 + ai * HALF + m * 16) * rstride) = w; } }
    }
};
__device__ __forceinline__ float silu_f(float x) { return x * __builtin_amdgcn_rcpf(1.0f + __expf(-x)); }
struct EpiSwiglu {
    static constexpr bool PERM = true, AFTER_DRAIN = false;
    bf16_t* O; int ldc;
    __device__ __forceinline__ void operator()(const f32x4 (&acc)[2][2][4][2], const Unit& u, int wr, int wc, int fr, int fq) const {
        const int row0 = u.pm * BM + wr * 64 + fr, col0 = u.pn * HALF + wc * 32 + 8 * fq;
#pragma unroll
        for (int ai = 0; ai < 2; ++ai)
#pragma unroll
            for (int m = 0; m < 4; ++m) { bf16_t* rowp = O + (size_t)(row0 + ai * HALF + m * 16) * ldc + col0;
                const f32x4 a0 = acc[ai][0][m][0], a1 = acc[ai][0][m][1], b0 = acc[ai][1][m][0], b1 = acc[ai][1][m][1];
                u32x4 w;
                w.x = cvt_pk_bf16(silu_f(a0[0]) * b0[0], silu_f(a0[1]) * b0[1]); w.y = cvt_pk_bf16(silu_f(a0[2]) * b0[2], silu_f(a0[3]) * b0[3]);
                w.z = cvt_pk_bf16(silu_f(a1[0]) * b1[0], silu_f(a1[1]) * b1[1]); w.w = cvt_pk_bf16(silu_f(a1[2]) * b1[2], silu_f(a1[3]) * b1[3]);
                *(u32x4*)rowp = w; }
    }
};
struct LatOrder {
    StaticOrder so;
    __device__ void init(int Mlat, int N, int G_, int c_) { so.init(Mlat, N, G_, c_); }
    __device__ bool next(int i, Unit& u) const { if (!so.next(i, u)) return false; u.pm += u.pm >> 5; return true; }
    __device__ __forceinline__ void a_ready(const Unit&) const {}
    __device__ __forceinline__ void done(const Unit&) const {}
};
struct CtxOrder {
    int c;
    __device__ bool next(int i, Unit& u) const { if (i > 0 || c >= 16) return false; u.pm = (c >> 2) * 33 + 32; u.pn = c & 3; return true; }
    __device__ __forceinline__ void a_ready(const Unit&) const {}
    __device__ __forceinline__ void done(const Unit&) const {}
};
struct CtxKvOrder {
    int c;
    __device__ bool next(int i, Unit& u) const { if (i > 0 || c >= 8) return false; u.pm = (c >> 1) * 33 + 32; u.pn = 4 + (c & 1); return true; }
    __device__ __forceinline__ void a_ready(const Unit&) const {}
    __device__ __forceinline__ void done(const Unit&) const {}
};
}
namespace attn {
using bf16 = __hip_bfloat16;
constexpr int   D = 128, NW = 8, QBLK = 32, KVBLK = 64;
constexpr float SCALE = 0.088388347648318440f;
constexpr float THR = 8.f;
constexpr int SDEPTH = 2;
constexpr int LDQ = 128, LDK = 128, LDO = 1024;
constexpr size_t SHM_V = KVBLK * D * 2, SHM_K = KVBLK * D * 2, SHM_ATTN = 2 * SHM_V + 2 * SHM_K + NW * 64 * 4;
using bf16x8 = __attribute__((ext_vector_type(8))) short;
using s16x4  = __attribute__((ext_vector_type(4))) short;
using f32x16 = __attribute__((ext_vector_type(16))) float;
using f32x8  = __attribute__((ext_vector_type(8))) float;
using u32x4  = __attribute__((ext_vector_type(4))) unsigned;
#define KSWZ(row, colB) ((row) * 256 + ((colB) ^ (((row) & 7) << 4)))
#define SBAR() __builtin_amdgcn_sched_barrier(0)
__device__ __forceinline__ int crow(int r, int hi) { return (r & 3) + 8 * (r >> 2) + 4 * hi; }
__device__ __forceinline__ unsigned cvtpk(float lo, float hi) {
  unsigned r; asm volatile("v_cvt_pk_bf16_f32 %0, %1, %2" : "=v"(r) : "v"(lo), "v"(hi)); return r;
}
template <typename TIn> struct Stage;
template <> struct Stage<bf16>  { using T = bf16x8;
  __device__ static __forceinline__ T ld8(const bf16* p) { return *reinterpret_cast<const bf16x8*>(p); }
  __device__ static __forceinline__ bf16x8 tobf(T x) { return x; } };
template <> struct Stage<float> { using T = f32x8;
  __device__ static __forceinline__ T ld8(const float* p) { return *reinterpret_cast<const f32x8*>(p); }
  __device__ static __forceinline__ bf16x8 tobf(T x) {
    u32x4 w = {cvtpk(x[0], x[1]), cvtpk(x[2], x[3]), cvtpk(x[4], x[5]), cvtpk(x[6], x[7])}; return *reinterpret_cast<bf16x8*>(&w); } };

__device__ __forceinline__ void partialSM(f32x16& p0, f32x16& p1, float& m_reg, float& mn, float& alpha) {
  constexpr float C = SCALE * 1.4426950408889634f;
  float pmax = p0[0]; for (int r = 1; r < 16; ++r) pmax = fmaxf(pmax, p0[r]); for (int r = 0; r < 16; ++r) pmax = fmaxf(pmax, p1[r]);
  { auto rr = __builtin_amdgcn_permlane32_swap(__float_as_uint(pmax), __float_as_uint(pmax), false, false);
    pmax = fmaxf(__uint_as_float(rr[0]), __uint_as_float(rr[1])); }
  if (__builtin_expect(__all(pmax - m_reg <= THR / SCALE), 1)) { mn = m_reg; alpha = 1.f; }
  else { mn = fmaxf(m_reg, pmax); alpha = __builtin_amdgcn_exp2f((m_reg - mn) * C); m_reg = mn; }
  float mnC = -mn * C;
  for (int r = 0; r < 16; ++r) p0[r] = fmaf(p0[r], C, mnC); for (int r = 0; r < 16; ++r) p1[r] = fmaf(p1[r], C, mnC);
  for (int r = 0; r < 16; ++r) p0[r] = __builtin_amdgcn_exp2f(p0[r]);
}
__device__ __forceinline__ void finishSM(f32x16& p0, f32x16& p1, float alpha, float& l_reg, bf16x8& pa0, bf16x8& pa1, bf16x8& pa2, bf16x8& pa3) {
  for (int r = 0; r < 16; ++r) p1[r] = __builtin_amdgcn_exp2f(p1[r]);
  float ps = 0; for (int r = 0; r < 16; ++r) ps += p0[r]; for (int r = 0; r < 16; ++r) ps += p1[r];
  { auto rr = __builtin_amdgcn_permlane32_swap(__float_as_uint(ps), __float_as_uint(ps), false, false);
    ps = __uint_as_float(rr[0]) + __uint_as_float(rr[1]); }
  l_reg = l_reg * alpha + ps;
#define PK4(P, BASE, OUT) do { unsigned a0 = cvtpk(P[BASE + 0], P[BASE + 1]), a1 = cvtpk(P[BASE + 2], P[BASE + 3]);   \
    unsigned b0 = cvtpk(P[BASE + 4], P[BASE + 5]), b1 = cvtpk(P[BASE + 6], P[BASE + 7]);                              \
    auto r0 = __builtin_amdgcn_permlane32_swap(a0, b0, false, false); auto r1 = __builtin_amdgcn_permlane32_swap(a1, b1, false, false); \
    u32x4 w = {r0[0], r1[0], r0[1], r1[1]}; OUT = *reinterpret_cast<bf16x8*>(&w); } while (0)
  PK4(p0, 0, pa0); PK4(p0, 8, pa1); PK4(p1, 0, pa2); PK4(p1, 8, pa3);
#undef PK4
}
__device__ __forceinline__ void qkt(f32x16& p0, f32x16& p1, const bf16* Ks, const bf16x8* qr, int r32, int hi) {
  p0 = f32x16{}; p1 = f32x16{};
  for (int d0 = 0; d0 < 8; ++d0) { int cb = (d0 * 16 + hi * 8) * 2;
    bf16x8 b0 = *reinterpret_cast<const bf16x8*>((const char*)Ks + KSWZ(r32, cb));
    bf16x8 b1 = *reinterpret_cast<const bf16x8*>((const char*)Ks + KSWZ(32 + r32, cb));
    p0 = __builtin_amdgcn_mfma_f32_32x32x16_bf16(b0, qr[d0], p0, 0, 0, 0);
    p1 = __builtin_amdgcn_mfma_f32_32x32x16_bf16(b1, qr[d0], p1, 0, 0, 0); }
}
__device__ __forceinline__ int v_st(int k, int c) { const int kk = (k & ~0xC) | ((k & 4) << 1) | ((k & 8) >> 1); return ((kk >> 3) * 4 + (c >> 5)) * 512 + ((kk & 7) * 32 + (c & 31)) * 2; }
__device__ __forceinline__ int v_rd_base(int lane) { return ((lane & 3) << 3) | (((lane >> 2) & 3) << 6) | (((lane >> 4) & 1) << 5) | (((lane >> 5) & 1) << 8); }
constexpr int v_rd_off(int d0, int ks, int half) { return d0 * 512 + ks * 4096 + half * 2048; }
template <int OFF> __device__ __forceinline__ s16x4 tr_read(int vb) {
  s16x4 r; asm volatile("ds_read_b64_tr_b16 %0, %1 offset:%2" : "=&v"(r) : "v"(vb), "i"(OFF) : "memory"); return r;
}
template <int D0> __device__ __forceinline__ void pv_one(f32x16& od, int vb, bf16x8 pa0, bf16x8 pa1, bf16x8 pa2, bf16x8 pa3) {
  const s16x4 l0 = tr_read<v_rd_off(D0, 0, 0)>(vb), h0 = tr_read<v_rd_off(D0, 0, 1)>(vb), l1 = tr_read<v_rd_off(D0, 1, 0)>(vb), h1 = tr_read<v_rd_off(D0, 1, 1)>(vb);
  const s16x4 l2 = tr_read<v_rd_off(D0, 2, 0)>(vb), h2 = tr_read<v_rd_off(D0, 2, 1)>(vb), l3 = tr_read<v_rd_off(D0, 3, 0)>(vb), h3 = tr_read<v_rd_off(D0, 3, 1)>(vb);
  asm volatile("s_waitcnt lgkmcnt(0)" ::: "memory"); SBAR();
#define PK(L, H) (bf16x8){L[0], L[1], L[2], L[3], H[0], H[1], H[2], H[3]}
  od = __builtin_amdgcn_mfma_f32_32x32x16_bf16(pa0, PK(l0, h0), od, 0, 0, 0);
  od = __builtin_amdgcn_mfma_f32_32x32x16_bf16(pa1, PK(l1, h1), od, 0, 0, 0);
  od = __builtin_amdgcn_mfma_f32_32x32x16_bf16(pa2, PK(l2, h2), od, 0, 0, 0);
  od = __builtin_amdgcn_mfma_f32_32x32x16_bf16(pa3, PK(l3, h3), od, 0, 0, 0);
#undef PK
}
__device__ __forceinline__ void pv_d0(f32x16* o, int vb, bf16x8 pa0, bf16x8 pa1, bf16x8 pa2, bf16x8 pa3) {
  pv_one<0>(o[0], vb, pa0, pa1, pa2, pa3); pv_one<1>(o[1], vb, pa0, pa1, pa2, pa3); pv_one<2>(o[2], vb, pa0, pa1, pa2, pa3); pv_one<3>(o[3], vb, pa0, pa1, pa2, pa3);
}

template <typename TQ>
__device__ __forceinline__ void attn_dense_body(const TQ* __restrict__ Qb, const bf16* __restrict__ Kh, const bf16* __restrict__ Vh,
                                                unsigned short* __restrict__ Ob, int seq, char* lds) {
  using St = Stage<bf16>; using SQ = Stage<TQ>;
  const int tid = threadIdx.x, wid = tid >> 6, lane = tid & 63, r32 = lane & 31, hi = lane >> 5;
  bf16* V_lds = (bf16*)lds; bf16* K_lds = (bf16*)(lds + 2 * SHM_V);
  float* ws = (float*)(lds + 2 * SHM_V + 2 * SHM_K) + wid * 64; float* li_l = ws; float* al_l = ws + 32;
  float m_reg = -1e30f, l_reg = 0; f32x16 o[4] = {}; bf16x8 qr[8];
  const TQ* Qw = Qb + (long)(wid * QBLK + r32) * LDQ + hi * 8;
#pragma unroll
  for (int d0 = 0; d0 < 8; ++d0) qr[d0] = SQ::tobf(SQ::ld8(Qw + d0 * 16));
  const int sr = tid >> 4, sc = (tid & 15) * 8, vst0 = v_st(sr, sc), vst1 = v_st(32 + sr, sc);
  const int vb0 = (int)(uintptr_t)V_lds + v_rd_base(lane);
  struct { typename St::T vs0, vs1, ks0, ks1; } sr_[SDEPTH];
#define SLOAD(i, k0) do { sr_[i].vs0 = St::ld8(&Vh[(long)((k0) + sr) * LDK + sc]); sr_[i].vs1 = St::ld8(&Vh[(long)((k0) + 32 + sr) * LDK + sc]); \
    sr_[i].ks0 = St::ld8(&Kh[(long)((k0) + sr) * LDK + sc]); sr_[i].ks1 = St::ld8(&Kh[(long)((k0) + 32 + sr) * LDK + sc]); } while (0)
#define SWRITE(b, i) do { *(bf16x8*)((char*)V_lds + (b) * SHM_V + vst0) = St::tobf(sr_[i].vs0);          \
    *(bf16x8*)((char*)V_lds + (b) * SHM_V + vst1) = St::tobf(sr_[i].vs1); int kc = sc * 2;               \
    *(bf16x8*)((char*)K_lds + (b) * SHM_K + KSWZ(sr, kc)) = St::tobf(sr_[i].ks0);                       \
    *(bf16x8*)((char*)K_lds + (b) * SHM_K + KSWZ(32 + sr, kc)) = St::tobf(sr_[i].ks1); } while (0)
#define SWAIT() do { if constexpr (SDEPTH == 2) asm volatile("s_waitcnt vmcnt(4)" ::: "memory"); else asm volatile("s_waitcnt vmcnt(0)" ::: "memory"); } while (0)
#define RESC(a) do { if (__any((a) < 1.f)) { if (hi == 0) al_l[r32] = (a); asm volatile("s_waitcnt lgkmcnt(0)" ::: "memory"); \
    for (int d = 0; d < 4; ++d) for (int r = 0; r < 16; ++r) o[d][r] *= al_l[crow(r, hi)]; } } while (0)
  f32x16 pA0, pA1, pB0, pB1; float mnA, mnB, alA, alB; bf16x8 pa0, pa1, pa2, pa3; const int NT = seq / KVBLK;
  constexpr int SE = 0, SO = SDEPTH - 1;
  SLOAD(SE, 0); asm volatile("s_waitcnt vmcnt(0)" ::: "memory"); SWRITE(0, SE); __syncthreads();
  qkt(pA0, pA1, K_lds, qr, r32, hi); partialSM(pA0, pA1, m_reg, mnA, alA);
  SLOAD(SO, KVBLK); if constexpr (SDEPTH == 2) { if (2 < NT) SLOAD(SE, 2 * KVBLK); }
  SWAIT(); SWRITE(1, SO); __syncthreads();
  for (int j = 1; j + 1 < NT; j += 2) {
    SBAR(); qkt(pB0, pB1, (bf16*)((char*)K_lds + SHM_K), qr, r32, hi);
    finishSM(pA0, pA1, alA, l_reg, pa0, pa1, pa2, pa3); SBAR();
    SLOAD(SO, (j + SDEPTH) * KVBLK); SBAR();
    pv_d0(o, vb0, pa0, pa1, pa2, pa3); partialSM(pB0, pB1, m_reg, mnB, alB);
    __syncthreads(); SWAIT(); SWRITE(0, SE);
    RESC(alB); __syncthreads();
    SBAR(); qkt(pA0, pA1, K_lds, qr, r32, hi);
    finishSM(pB0, pB1, alB, l_reg, pa0, pa1, pa2, pa3); SBAR();
    { const int jn = (j + 1 + SDEPTH < NT) ? (j + 1 + SDEPTH) : (NT - 1); SLOAD(SE, jn * KVBLK); } SBAR();
    pv_d0(o, vb0 + (int)SHM_V, pa0, pa1, pa2, pa3); partialSM(pA0, pA1, m_reg, mnA, alA);
    __syncthreads(); SWAIT(); SWRITE(1, SO);
    RESC(alA); __syncthreads();
  }
  SBAR(); qkt(pB0, pB1, (bf16*)((char*)K_lds + SHM_K), qr, r32, hi);
  finishSM(pA0, pA1, alA, l_reg, pa0, pa1, pa2, pa3); SBAR();
  pv_d0(o, vb0, pa0, pa1, pa2, pa3); partialSM(pB0, pB1, m_reg, mnB, alB);
  __syncthreads(); RESC(alB);
  finishSM(pB0, pB1, alB, l_reg, pa0, pa1, pa2, pa3); SBAR();
  pv_d0(o, vb0 + (int)SHM_V, pa0, pa1, pa2, pa3);
  if (hi == 0) li_l[r32] = l_reg; asm volatile("s_waitcnt lgkmcnt(0)" ::: "memory");
  float rli[16];
#pragma unroll
  for (int r = 0; r < 16; ++r) rli[r] = __builtin_amdgcn_rcpf(li_l[crow(r, hi)]);
  unsigned short* Ow = Ob + (long)(wid * QBLK) * LDO;
#pragma unroll
  for (int r = 0; r < 16; ++r) { int orow = crow(r, hi);
    for (int d0 = 0; d0 < 4; ++d0) Ow[(long)orow * LDO + d0 * 32 + r32] = (unsigned short)(cvtpk(o[d0][r] * rli[r], 0.f) & 0xffffu); }
#undef SLOAD
#undef SWRITE
#undef SWAIT
#undef RESC
}
}
namespace mk {
typedef unsigned short bf16_t;
typedef short bf16x8 __attribute__((ext_vector_type(8)));
typedef float f32x4 __attribute__((ext_vector_type(4)));
typedef unsigned u32x4 __attribute__((ext_vector_type(4)));
typedef unsigned u32x2 __attribute__((ext_vector_type(2)));
#define LAS __attribute__((address_space(3)))
constexpr int NWAVES = 8, NTHR = 512;
constexpr int DM = 1024, NB = 4, SEQL = 8192, CTXL = 256, ROWS_B = SEQL + CTXL  , MROWS = NB * ROWS_B  , MLAT = NB * SEQL;
constexpr int ABIN = 3072, FFH = 2816, FFIN = 2 * FFH, ATTIN = 1536;
constexpr int NCHUNK = ROWS_B / 64  , NCHAIN = 32, NTASK_A = NCHAIN * NCHUNK  , NTASK_POOL = MROWS / 64  , NTASK_C = 16 * NCHUNK  ;
constexpr float EPS = 1e-6f;
constexpr size_t MiB = 1u << 20;
constexpr size_t WS_CTL = 0, CTL_ZERO_BYTES = 512 * 1024, WS_MODS = 256 * 1024;
constexpr size_t WS_W_ABIN = 2 * MiB, WS_W_ABOUT = 8 * MiB, WS_W_ATTIN = 10 * MiB, WS_W_ATTOUT = 13 * MiB, WS_W_FFIN = 15 * MiB, WS_W_FFOUT = 37 * MiB;
constexpr size_t WS_POOLWT = 48 * MiB, WS_DEC = 49 * MiB, WS_CTXS = 52 * MiB;
constexpr size_t WS_XN = 60 * MiB, WS_Y = 126 * MiB, WS_SB = 60 * MiB, WS_Z = 192 * MiB, WS_MIX = 390 * MiB, WS_END = 456 * MiB;
constexpr size_t WS_QC = 292 * MiB, WS_KC = 356 * MiB, WS_VC = 373 * MiB;
constexpr int LDS_BYTES = 147456;
constexpr int N_PHASES = 19;

__device__ __forceinline__ float bf2f(bf16_t h) { return __uint_as_float((unsigned)h << 16); }
typedef __bf16 bf16x2_t __attribute__((ext_vector_type(2)));
typedef float f32x2_t __attribute__((ext_vector_type(2)));
__device__ __forceinline__ unsigned cvtpk(float lo, float hi) { const f32x2_t f = {lo, hi}; const bf16x2_t v = __builtin_convertvector(f, bf16x2_t); return __builtin_bit_cast(unsigned, v); }
__device__ __forceinline__ unsigned f2bf(float f) { return cvtpk(f, 0.f) & 0xffffu; }
__device__ __forceinline__ unsigned pk2(float lo, float hi) { return cvtpk(lo, hi); }
__device__ __forceinline__ float sigmoid_f(float x) { return 1.0f / (1.0f + __expf(-x)); }
template <int CTRL, int ROWMASK> __device__ __forceinline__ float dpp_get(float v) { return __builtin_bit_cast(float, __builtin_amdgcn_update_dpp(0, __builtin_bit_cast(int, v), CTRL, ROWMASK, 0xf, false)); }
__device__ __forceinline__ float row16_sum(float v) { v += dpp_get<0xB1, 0xf>(v); v += dpp_get<0x4E, 0xf>(v); v += dpp_get<0x141, 0xf>(v); v += dpp_get<0x140, 0xf>(v); return v; }
__device__ __forceinline__ float wave_sum(float v) {
    v = row16_sum(v); v += dpp_get<0x142, 0xa>(v); v += dpp_get<0x143, 0xc>(v);
    return __builtin_bit_cast(float, __builtin_amdgcn_readlane(__builtin_bit_cast(int, v), 63));
}

__device__ __forceinline__ void transpose_item(const float* W, int K, int N, bf16_t* WT, int k0, int n0, int drow0, float* scr, int lane) {
#pragma unroll
    for (int i = 0; i < 8; ++i) { const int kk = 8 * i + (lane >> 3), n4 = (lane & 7) * 4; const f32x4 v = *(const f32x4*)(W + (size_t)(k0 + kk) * N + n0 + n4);
        scr[kk * 33 + n4] = v.x; scr[kk * 33 + n4 + 1] = v.y; scr[kk * 33 + n4 + 2] = v.z; scr[kk * 33 + n4 + 3] = v.w; }
    asm volatile("s_waitcnt lgkmcnt(0)" ::: "memory");
    const int c = lane & 7;
#pragma unroll
    for (int j = 0; j < 4; ++j) { const int n = (lane >> 3) + 8 * j; const float* s = scr + (8 * c) * 33 + n;
        u32x4 o; o.x = pk2(s[0 * 33], s[1 * 33]); o.y = pk2(s[2 * 33], s[3 * 33]); o.z = pk2(s[4 * 33], s[5 * 33]); o.w = pk2(s[6 * 33], s[7 * 33]);
        *(u32x4*)(WT + (size_t)(drow0 + n) * K + k0 + 8 * c) = o; }
    asm volatile("s_waitcnt lgkmcnt(0)" ::: "memory");
}
__device__ __forceinline__ void transpose_plain(const float* W, int K, int N, bf16_t* WT, int item, float* scr, int lane) {
    const int nblk = N / 32, kb = item / nblk, nb = item % nblk; transpose_item(W, K, N, WT, 64 * kb, 32 * nb, 32 * nb, scr, lane);
}
__device__ __forceinline__ void transpose_abin(const float* W, bf16_t* WT, int item, float* scr, int lane) {
    const int nblk = ABIN / 32, kb = item / nblk, nb = item % nblk; const int n0 = 32 * nb;
    int drow0; if (n0 < 512) drow0 = n0; else { const int grp = (n0 - 512) / 512, hh = ((n0 - 512) % 512) / 128, j0 = n0 % 128; drow0 = 512 + hh * 640 + grp * 128 + j0; }
    transpose_item(W, DM, ABIN, WT, 64 * kb, n0, drow0, scr, lane);
}
__device__ __forceinline__ void transpose_ffin(const float* W, bf16_t* WT, int item, float* scr, int lane) {
    const int nblk = FFIN / 32, kb = item / nblk, nb = item % nblk; const int n0 = 32 * nb;
    int drow0; if (n0 < FFH) drow0 = 256 * (n0 / 128) + (n0 % 128); else { const int m0 = n0 - FFH; drow0 = 256 * (m0 / 128) + 128 + (m0 % 128); }
    transpose_item(W, DM, FFIN, WT, 64 * kb, n0, drow0, scr, lane);
}
__device__ __forceinline__ void ada_item(int item, const float* c, const float* c_ctx, const float* ada_w, const float* ada_b, float* mods, int lane) {
    const int kc = item & 15, nb = (item >> 4) % 96, l = item / (16 * 96);
    const int k0 = kc * 64, n = nb * 64 + lane;
    float sv[5];
#pragma unroll
    for (int r = 0; r < 5; ++r) { const float v = (r < 4) ? c[r * DM + k0 + lane] : c_ctx[k0 + lane]; sv[r] = v * sigmoid_f(v); }
    float acc[5] = {0.f, 0.f, 0.f, 0.f, 0.f};
    const float* wp = ada_w + ((size_t)l * DM + k0) * 6144 + n;
#pragma unroll 16
    for (int kk = 0; kk < 64; ++kk) { const float w = wp[(size_t)kk * 6144];
#pragma unroll
        for (int r = 0; r < 5; ++r) acc[r] += __shfl(sv[r], kk) * w; }
    const float bias = (kc == 0) ? ada_b[l * 6144 + n] : 0.f;
#pragma unroll
    for (int r = 0; r < 5; ++r) atomicAdd(mods + ((size_t)l * 5 + r) * 6144 + n, acc[r] + bias);
}

struct RowRegs { f32x4 v[4]; u32x2 yw[4]; };
template <bool HAS_Y>
__device__ __forceinline__ void row_load(RowRegs& R, int row, bool on, int lane, const float* xin_lat, const float* xin_ctx, const bf16_t* Y) {
    if (!on) return;
    const int b = row / ROWS_B, p = row - b * ROWS_B; const bool isctx = p >= SEQL;
    const size_t xoff = isctx ? (size_t)(b * CTXL + p - SEQL) * DM : (size_t)(b * SEQL + p) * DM;
    const float* xin = (isctx ? xin_ctx : xin_lat) + xoff;
#pragma unroll
    for (int j = 0; j < 4; ++j) R.v[j] = __builtin_nontemporal_load((const f32x4*)(xin + 4 * lane + 256 * j));
    if (HAS_Y) { const bf16_t* yr = Y + (size_t)row * DM;
#pragma unroll
        for (int j = 0; j < 4; ++j) R.yw[j] = __builtin_nontemporal_load((const u32x2*)(yr + 4 * lane + 256 * j)); }
}
template <bool HAS_Y, bool WRITE_X, bool HAS_XN>
__device__ __forceinline__ void row_finish(RowRegs& R, int row, bool on, int lane, float* xout_lat, float* xout_ctx, const float* PRM, bf16_t* XN) {
    if (!on) return;
    const int b = row / ROWS_B, p = row - b * ROWS_B; const bool isctx = p >= SEQL; const int r = isctx ? 4 : b;
    const size_t xoff = isctx ? (size_t)(b * CTXL + p - SEQL) * DM : (size_t)(b * SEQL + p) * DM;
    const float* PG = PRM + r * DM; const float* PA = PRM + 5 * DM + r * DM; const float* PS = PRM + 10 * DM + r * DM;
    f32x4 (&v)[4] = R.v;
    if (HAS_Y) {
        f32x4 y[4]; float ss = 0.f;
#pragma unroll
        for (int j = 0; j < 4; ++j) { const u32x2 w = R.yw[j];
            y[j] = (f32x4){__uint_as_float(w.x << 16), __uint_as_float(w.x & 0xffff0000u), __uint_as_float(w.y << 16), __uint_as_float(w.y & 0xffff0000u)};
            ss += (y[j].x * y[j].x + y[j].y * y[j].y) + (y[j].z * y[j].z + y[j].w * y[j].w); }
        const float rstd = rsqrtf(wave_sum(ss) * (1.f / DM) + EPS);
#pragma unroll
        for (int j = 0; j < 4; ++j) { const f32x4 g = *(const f32x4*)(PG + 4 * lane + 256 * j); v[j] = v[j] + g * (y[j] * rstd); }
    }
    if (WRITE_X) { float* xo = (isctx ? xout_ctx : xout_lat) + xoff;
#pragma unroll
        for (int j = 0; j < 4; ++j) __builtin_nontemporal_store(v[j], (f32x4*)(xo + 4 * lane + 256 * j)); }
    if (HAS_XN) {
        float ss = 0.f;
#pragma unroll
        for (int j = 0; j < 4; ++j) ss += (v[j].x * v[j].x + v[j].y * v[j].y) + (v[j].z * v[j].z + v[j].w * v[j].w);
        const float rstd = rsqrtf(wave_sum(ss) * (1.f / DM) + EPS);
        bf16_t* xo = XN + (size_t)row * DM;
#pragma unroll
        for (int j = 0; j < 4; ++j) { const f32x4 pa = *(const f32x4*)(PA + 4 * lane + 256 * j), sh = *(const f32x4*)(PS + 4 * lane + 256 * j);
            const f32x4 o = v[j] * rstd * pa + sh;
            u32x2 w; w.x = pk2(o.x, o.y); w.y = pk2(o.z, o.w); *(u32x2*)(xo + 4 * lane + 256 * j) = w; }
    }
}
template <bool HAS_Y, bool WRITE_X, bool HAS_XN>
__device__ __forceinline__ void row_phase(int gw, int NGW, int lane, int tid, float* PRM  , int rmode  ,
        const float* xin_lat, const float* xin_ctx, float* xout_lat, float* xout_ctx,
        const bf16_t* Y, const float* mods_y, int gate_idx, const float* ngy,
        const float* ng2, const float* mods_n, int sh_idx, int sc_idx, bf16_t* XN) {
    for (int idx = tid; idx < 5 * DM; idx += NTHR) { const int r = idx >> 10, c = idx & (DM - 1);
        if (HAS_Y) PRM[idx] = mods_y[((size_t)r * 6 + gate_idx) * DM + c] * ngy[c];
        if (HAS_XN) { PRM[5 * DM + idx] = ng2[c] * (1.0f + mods_n[((size_t)r * 6 + sc_idx) * DM + c]); PRM[10 * DM + idx] = mods_n[((size_t)r * 6 + sh_idx) * DM + c]; } }
    __syncthreads();
#define ROW_ON(rr) (((rr) < MROWS) && (rmode == 0 || ((((rr) % ROWS_B) >= SEQL) == (rmode == 2))))
    RowRegs A, B, C, D;
    int row = gw;
    if (row < MROWS) {
        row_load<HAS_Y>(A, row, ROW_ON(row), lane, xin_lat, xin_ctx, Y); row_load<HAS_Y>(B, row + NGW, ROW_ON(row + NGW), lane, xin_lat, xin_ctx, Y);
        for (;;) {
            int nrow = row + 2 * NGW; bool more = nrow < MROWS;
            if (more) { row_load<HAS_Y>(C, nrow, ROW_ON(nrow), lane, xin_lat, xin_ctx, Y); row_load<HAS_Y>(D, nrow + NGW, ROW_ON(nrow + NGW), lane, xin_lat, xin_ctx, Y); }
            row_finish<HAS_Y, WRITE_X, HAS_XN>(A, row, ROW_ON(row), lane, xout_lat, xout_ctx, PRM, XN);
            row_finish<HAS_Y, WRITE_X, HAS_XN>(B, row + NGW, ROW_ON(row + NGW), lane, xout_lat, xout_ctx, PRM, XN);
            if (!more) break;
            row = nrow; nrow = row + 2 * NGW; more = nrow < MROWS;
            if (more) { row_load<HAS_Y>(A, nrow, ROW_ON(nrow), lane, xin_lat, xin_ctx, Y); row_load<HAS_Y>(B, nrow + NGW, ROW_ON(nrow + NGW), lane, xin_lat, xin_ctx, Y); }
            row_finish<HAS_Y, WRITE_X, HAS_XN>(C, row, ROW_ON(row), lane, xout_lat, xout_ctx, PRM, XN);
            row_finish<HAS_Y, WRITE_X, HAS_XN>(D, row + NGW, ROW_ON(row + NGW), lane, xout_lat, xout_ctx, PRM, XN);
            if (!more) break;
            row = nrow;
        }
    }
#undef ROW_ON
    __syncthreads();
}

__device__ __forceinline__ float lb_of(const float* hg_lower, int dir, int ch) { const float a0 = hg_lower[dir * 512 + ch], a1 = hg_lower[1024 + dir * 512 + ch]; return 1.0f / (1.0f + __expf(a1 - a0)); }


__device__ __forceinline__ void tile_load(u32x4 (&r)[2], const bf16_t* base, int ld, int tid) {
#pragma unroll
    for (int k = 0; k < 2; ++k) { const int idx = tid + 512 * k; r[k] = *(const u32x4*)(base + (size_t)(idx >> 4) * ld + (idx & 15) * 8); }
}
__device__ __forceinline__ void tile_to_lds(const u32x4 (&r)[2], bf16_t* dst  , int tid) {
#pragma unroll
    for (int k = 0; k < 2; ++k) { const int idx = tid + 512 * k; *(u32x4*)(dst + idx * 8) = r[k]; }
}
struct Gate { float f[16], kv[16]; float run; };
__device__ __forceinline__ void gate_math(Gate& G_, const bf16_t* ZR, float lbv, int d, int seg) {
    float run = 1.f;
#pragma unroll
    for (int ii = 0; ii < 16; ++ii) { const float z = bf2f(ZR[(seg * 16 + ii) * 128 + d]); const float sg = __builtin_amdgcn_rcpf(1.0f + __expf(-z)); const float f = lbv + (1.f - lbv) * sg;
        G_.kv[ii] = (1.f - lbv) * (1.f - sg); G_.f[ii] = f; run *= f; }
    G_.run = run;
}
__device__ __forceinline__ void hgrn_a_load(int task, const bf16_t* Z, u32x4 (&rzf)[2], u32x4 (&rzb)[2], u32x4 (&rv)[2], int tid) {
    const int bh = task / NCHUNK, nc = task - bh * NCHUNK, b = bh >> 2, h = bh & 3;
    const int row0 = b * ROWS_B + (nc < 128 ? nc * 64 : SEQL + (nc - 128) * 64);
    const bf16_t* zb_ = Z + ((size_t)h * MROWS + row0) * 640;
    tile_load(rzf, zb_ + 128, 640, tid); tile_load(rzb, zb_ + 256, 640, tid); tile_load(rv, zb_ + 384, 640, tid);
}
__device__ __forceinline__ void hgrn_a_task(int task, int next_task, u32x4 (&rzf)[2], u32x4 (&rzb)[2], u32x4 (&rv)[2], const bf16_t* Z, const float* hg_lower, bf16_t* SB, float* DEC, char* lds, int tid) {
    const int bh = task / NCHUNK, nc = task - bh * NCHUNK, b = bh >> 2, h = bh & 3;
    const int row0 = b * ROWS_B + (nc < 128 ? nc * 64 : SEQL + (nc - 128) * 64);
    bf16_t* RZF = (bf16_t*)lds;
    bf16_t* RZB = (bf16_t*)(lds + 16384);
    bf16_t* RV = (bf16_t*)(lds + 32768);
    bf16_t* KT0 = (bf16_t*)(lds + 49152);
    bf16_t* VT = (bf16_t*)(lds + 49152 + 2 * 18432);
    float* TOT = (float*)(lds + 49152 + 3 * 18432);
    const int d = tid & 127, seg = tid >> 7, ch = h * 128 + d;
    const float lb0 = lb_of(hg_lower, 0, ch), lb1 = lb_of(hg_lower, 1, ch);
    tile_to_lds(rzf, RZF, tid); tile_to_lds(rzb, RZB, tid); tile_to_lds(rv, RV, tid);
    __syncthreads();
    if (next_task >= 0) hgrn_a_load(next_task, Z, rzf, rzb, rv, tid);
    {
        unsigned w[8];
#pragma unroll
        for (int i2 = 0; i2 < 8; ++i2) w[i2] = (unsigned)RV[(seg * 16 + 2 * i2) * 128 + d] | ((unsigned)RV[(seg * 16 + 2 * i2 + 1) * 128 + d] << 16);
        *(u32x4*)(VT + d * 72 + seg * 16) = (u32x4){w[0], w[1], w[2], w[3]}; *(u32x4*)(VT + d * 72 + seg * 16 + 8) = (u32x4){w[4], w[5], w[6], w[7]};
    }
    Gate g0, g1;
    gate_math(g0, RZF, lb0, d, seg); gate_math(g1, RZB, lb1, d, seg);
    TOT[seg * 128 + d] = g0.run; TOT[512 + seg * 128 + d] = g1.run;
    __syncthreads();
#pragma unroll
    for (int dir = 0; dir < 2; ++dir) {
        const Gate& gg = dir ? g1 : g0;
        float offp = 1.f, offs = 1.f;
#pragma unroll
        for (int s = 0; s < 4; ++s) { const float tv = TOT[dir * 512 + s * 128 + d]; if (s < seg) offp *= tv; if (s > seg) offs *= tv; }
        const float total = offp * gg.run * offs;
        float kk[16];
        if (dir == 0) { float acc = offs;
#pragma unroll
            for (int ii = 15; ii >= 0; --ii) { kk[ii] = gg.kv[ii] * acc; acc *= gg.f[ii]; } }
        else { float acc = offp;
#pragma unroll
            for (int ii = 0; ii < 16; ++ii) { kk[ii] = gg.kv[ii] * acc; acc *= gg.f[ii]; } }
        unsigned w[8];
#pragma unroll
        for (int i2 = 0; i2 < 8; ++i2) w[i2] = cvtpk(kk[2 * i2], kk[2 * i2 + 1]);
        bf16_t* KT = KT0 + dir * (128 * 72);
        *(u32x4*)(KT + d * 72 + seg * 16) = (u32x4){w[0], w[1], w[2], w[3]}; *(u32x4*)(KT + d * 72 + seg * 16 + 8) = (u32x4){w[4], w[5], w[6], w[7]};
        if (seg == 0) { const int cc = (nc < 128) ? (dir ? 4 + (127 - nc) : 4 + nc) : (dir ? 3 - (nc - 128) : (nc - 128)); const int t = ((dir * 4 + b) * 4 + h) * NCHUNK + cc; DEC[(size_t)t * 128 + d] = total; }
    }
    __syncthreads();
    const int wave = tid >> 6, lane = tid & 63, fr = lane & 15, fq = lane >> 4;
#pragma unroll
    for (int dir = 0; dir < 2; ++dir) {
        const bf16_t* KT = KT0 + dir * (128 * 72);
        const int cc = (nc < 128) ? (dir ? 4 + (127 - nc) : 4 + nc) : (dir ? 3 - (nc - 128) : (nc - 128)); const int t = ((dir * 4 + b) * 4 + h) * NCHUNK + cc;
        bf16x8 a[2];
#pragma unroll
        for (int ks = 0; ks < 2; ++ks) a[ks] = *(const bf16x8*)(KT + (wave * 16 + fr) * 72 + ks * 32 + fq * 8);
#pragma unroll
        for (int et = 0; et < 8; ++et) { f32x4 acc = {0.f, 0.f, 0.f, 0.f};
#pragma unroll
            for (int ks = 0; ks < 2; ++ks) { const bf16x8 bv = *(const bf16x8*)(VT + (et * 16 + fr) * 72 + ks * 32 + fq * 8); acc = __builtin_amdgcn_mfma_f32_16x16x32_bf16(a[ks], bv, acc, 0, 0, 0); }
            u32x2 w; w.x = cvtpk(acc[0], acc[1]); w.y = cvtpk(acc[2], acc[3]);
            *(u32x2*)((bf16_t*)(lds + (dir ? 108544 : 0)) + (et * 16 + fr) * 136 + wave * 16 + fq * 4) = w; }
    }
    __syncthreads();
#pragma unroll
    for (int dir = 0; dir < 2; ++dir) {
        const int cc = (nc < 128) ? (dir ? 4 + (127 - nc) : 4 + nc) : (dir ? 3 - (nc - 128) : (nc - 128)); const int t = ((dir * 4 + b) * 4 + h) * NCHUNK + cc;
        const bf16_t* OSB = (const bf16_t*)(lds + (dir ? 108544 : 0));
#pragma unroll
        for (int k = 0; k < 4; ++k) { const int idx = tid + 512 * k; *(u32x4*)(SB + (size_t)t * 16384 + idx * 8) = *(const u32x4*)(OSB + (idx >> 4) * 136 + (idx & 15) * 8); }
    }
    __syncthreads();
}

__device__ __forceinline__ void pool_task(int nt, const bf16_t* Z, const bf16_t* PWT, const float* pool_scale, bf16_t* MIX, char* lds, int tid) {
    const int row0 = nt * 64, b = row0 / ROWS_B, p0 = row0 - b * ROWS_B; const bool isctx = p0 >= SEQL;
    const int seg_lo = b * ROWS_B + (isctx ? SEQL : 0), Ln = isctx ? CTXL : SEQL, t0 = row0 - seg_lo;
    bf16_t* UR = (bf16_t*)lds;
    bf16_t* YH = (bf16_t*)(lds + 80 * 512 * 2);
    {
        u32x4 r[10];
#pragma unroll
        for (int k = 0; k < 10; ++k) { const int idx = tid + 512 * k, jj = idx >> 6, c8 = idx & 63; const int tp = t0 - 8 + jj; const int tpc = min(max(tp, 0), Ln - 1);
            r[k] = *(const u32x4*)(Z + (size_t)(seg_lo + tpc) * 512 + c8 * 8); if (tp != tpc) r[k] = (u32x4){0u, 0u, 0u, 0u}; }
#pragma unroll
        for (int k = 0; k < 10; ++k) { const int idx = tid + 512 * k; *(u32x4*)(UR + idx * 8) = r[k]; }
    }
    __syncthreads();
    const int c = tid & 127, rs = tid >> 7;
    const int wave = tid >> 6, lane = tid & 63, fr = lane & 15, fq = lane >> 4;
    for (int g = 0; g < 4; ++g) {
        const int half = 1 << g; const bf16_t* U = UR + g * 128 + c;
        {
            int t = t0 + rs * 16; int lo = max(t - half, 0), hi = min(t + half, Ln); float s = 0.f;
            for (int j = lo; j < hi; ++j) s += bf2f(U[(j - t0 + 8) * 512]);
            for (int ii = 0; ii < 16; ++ii) { const int n = rs * 16 + ii; t = t0 + n;
                const float y = s * __builtin_amdgcn_rcpf((float)(hi - lo)) - bf2f(U[(n + 8) * 512]); YH[n * 136 + c] = (bf16_t)f2bf(y);
                const int nlo = max(t + 1 - half, 0), nhi = min(t + 1 + half, Ln);
                if (nhi > hi) s += bf2f(U[(nhi - 1 - t0 + 8) * 512]);
                if (nlo > lo) s -= bf2f(U[(lo - t0 + 8) * 512]);
                lo = nlo; hi = nhi; }
        }
        bf16x8 a[4];
#pragma unroll
        for (int ks = 0; ks < 4; ++ks) a[ks] = *(const bf16x8*)(PWT + (size_t)g * 16384 + (wave * 16 + fr) * 128 + ks * 32 + fq * 8);
        const f32x4 ps = *(const f32x4*)(pool_scale + g * 128 + wave * 16 + fq * 4);
        __syncthreads();
#pragma unroll
        for (int ntile = 0; ntile < 4; ++ntile) { f32x4 acc = {0.f, 0.f, 0.f, 0.f};
#pragma unroll
            for (int ks = 0; ks < 4; ++ks) { const bf16x8 bv = *(const bf16x8*)(YH + (ntile * 16 + fr) * 136 + ks * 32 + fq * 8); acc = __builtin_amdgcn_mfma_f32_16x16x32_bf16(a[ks], bv, acc, 0, 0, 0); }
            acc = acc * ps; u32x2 w; w.x = cvtpk(acc[0], acc[1]); w.y = cvtpk(acc[2], acc[3]);
            *(u32x2*)(MIX + (size_t)(row0 + ntile * 16 + fr) * DM + g * 128 + wave * 16 + fq * 4) = w; }
        __syncthreads();
    }
}

__device__ __forceinline__ void hgrn_b(int vcu, int G, int tid, bf16_t* SB, const float* DEC) {
    for (int idx = vcu * NTHR + tid; idx < NCHAIN * 4096; idx += G * NTHR) {
        const int chain = idx >> 12, rem = idx & 4095, dq = rem & 31;
        f32x4 S = {0.f, 0.f, 0.f, 0.f};
        bf16_t* p = SB + (size_t)chain * NCHUNK * 16384 + rem * 4; const float* dp = DEC + (size_t)chain * NCHUNK * 128 + dq * 4;
#pragma unroll 22
        for (int cc = 0; cc < NCHUNK; ++cc) {
            const u32x2 w = *(const u32x2*)(p + (size_t)cc * 16384); const f32x4 dec = *(const f32x4*)(dp + cc * 128);
            u32x2 o; o.x = pk2(S.x, S.y); o.y = pk2(S.z, S.w); *(u32x2*)(p + (size_t)cc * 16384) = o;
            const f32x4 ds = {__uint_as_float(w.x << 16), __uint_as_float(w.x & 0xffff0000u), __uint_as_float(w.y << 16), __uint_as_float(w.y & 0xffff0000u)};
            S = dec * S + ds;
        }
    }
}

__device__ __forceinline__ void hgrn_c_load(int task, const bf16_t* Z, u32x4 (&rq)[2], u32x4 (&rzf)[2], u32x4 (&rv)[2], int tid) {
    const int bh = task / NCHUNK, nc = task - bh * NCHUNK, b = bh >> 2, h = bh & 3;
    const int row0 = b * ROWS_B + (nc < 128 ? nc * 64 : SEQL + (nc - 128) * 64);
    const bf16_t* zb_ = Z + ((size_t)h * MROWS + row0) * 640;
    tile_load(rq, zb_, 640, tid); tile_load(rzf, zb_ + 128, 640, tid); tile_load(rv, zb_ + 384, 640, tid);
}
__device__ __forceinline__ void hgrn_c_task(int task, int next_task, u32x4 (&rq)[2], u32x4 (&rzf)[2], u32x4 (&rv)[2], const bf16_t* Z, const float* hg_lower, const float* onorm_g, const bf16_t* SB, bf16_t* MIX, char* lds, int tid) {
    const int bh = task / NCHUNK, nc = task - bh * NCHUNK, b = bh >> 2, h = bh & 3;
    const int row0 = b * ROWS_B + (nc < 128 ? nc * 64 : SEQL + (nc - 128) * 64);
    bf16_t* QH = (bf16_t*)lds;
    bf16_t* KH = (bf16_t*)(lds + 17408);
    bf16_t* VT = (bf16_t*)(lds + 34816);
    bf16_t* P = (bf16_t*)(lds + 53248);
    float* TOT = (float*)(lds + 62464);
    bf16_t* RQ = (bf16_t*)(lds + 64512);
    bf16_t* RZ = (bf16_t*)(lds + 80896);
    bf16_t* SL = (bf16_t*)(lds + 97280);
    bf16_t* RV = SL;
    float* OS = (float*)lds;
    const int d = tid & 127, seg = tid >> 7, ch = h * 128 + d;
    const int wave = tid >> 6, lane = tid & 63, fr = lane & 15, fq = lane >> 4;
    const int it = wave & 3, et0 = (wave >> 2) * 4, mt0 = (wave >> 2) * 2;
    u32x4 rzb[2], rg[2], rs0[4], rs1[4];
    const bf16_t* zb_ = Z + ((size_t)h * MROWS + row0) * 640;
    tile_load(rzb, zb_ + 256, 640, tid); tile_load(rg, zb_ + 512, 640, tid);
    {
        const int cc0 = (nc < 128) ? 4 + nc : (nc - 128), cc1 = (nc < 128) ? 4 + (127 - nc) : 3 - (nc - 128);
        const bf16_t* S0 = SB + (size_t)(((0 * 4 + b) * 4 + h) * NCHUNK + cc0) * 16384; const bf16_t* S1 = SB + (size_t)(((1 * 4 + b) * 4 + h) * NCHUNK + cc1) * 16384;
#pragma unroll
        for (int k = 0; k < 4; ++k) { rs0[k] = *(const u32x4*)(S0 + (tid + 512 * k) * 8); rs1[k] = *(const u32x4*)(S1 + (tid + 512 * k) * 8); }
    }
    const float lb0 = lb_of(hg_lower, 0, ch), lb1 = lb_of(hg_lower, 1, ch);
    tile_to_lds(rq, RQ, tid); tile_to_lds(rzf, RZ, tid); tile_to_lds(rv, RV, tid);
    __syncthreads();
    if (next_task >= 0) hgrn_c_load(next_task, Z, rq, rzf, rv, tid);
    float qv[16];
    {
        unsigned w[8];
#pragma unroll
        for (int i2 = 0; i2 < 8; ++i2) w[i2] = (unsigned)RV[(seg * 16 + 2 * i2) * 128 + d] | ((unsigned)RV[(seg * 16 + 2 * i2 + 1) * 128 + d] << 16);
        *(u32x4*)(VT + d * 72 + seg * 16) = (u32x4){w[0], w[1], w[2], w[3]}; *(u32x4*)(VT + d * 72 + seg * 16 + 8) = (u32x4){w[4], w[5], w[6], w[7]};
#pragma unroll
        for (int ii = 0; ii < 16; ++ii) { const float q = bf2f(RQ[(seg * 16 + ii) * 128 + d]); qv[ii] = q * __builtin_amdgcn_rcpf(1.0f + __expf(-q)); }
    }
    f32x4 oacc[4];
#pragma unroll
    for (int j = 0; j < 4; ++j) oacc[j] = (f32x4){0.f, 0.f, 0.f, 0.f};
#pragma unroll
    for (int dir = 0; dir < 2; ++dir) {
        Gate gg;
        gate_math(gg, dir ? RQ : RZ, dir ? lb1 : lb0, d, seg);
        TOT[seg * 128 + d] = gg.run;
        __syncthreads();
        if (dir == 0) tile_to_lds(rzb, RQ, tid);
#pragma unroll
        for (int k = 0; k < 4; ++k) { const int idx = tid + 512 * k; *(u32x4*)(SL + (idx >> 4) * 136 + (idx & 15) * 8) = dir ? rs1[k] : rs0[k]; }
        float offp = 1.f, offs = 1.f;
#pragma unroll
        for (int s = 0; s < 4; ++s) { const float tv = TOT[s * 128 + d]; if (s < seg) offp *= tv; if (s > seg) offs *= tv; }
        if (dir == 0) { float acc = offp;
#pragma unroll
            for (int ii = 0; ii < 16; ++ii) { acc *= gg.f[ii];
                QH[(seg * 16 + ii) * 136 + d] = (bf16_t)f2bf(qv[ii] * acc); KH[(seg * 16 + ii) * 136 + d] = (bf16_t)f2bf(gg.kv[ii] * __builtin_amdgcn_rcpf(acc)); } }
        else { float acc = offs;
#pragma unroll
            for (int ii = 15; ii >= 0; --ii) { acc *= gg.f[ii];
                QH[(seg * 16 + ii) * 136 + d] = (bf16_t)f2bf(qv[ii] * acc); KH[(seg * 16 + ii) * 136 + d] = (bf16_t)f2bf(gg.kv[ii] * __builtin_amdgcn_rcpf(acc)); } }
        __syncthreads();
        bf16x8 aq[4];
#pragma unroll
        for (int ks = 0; ks < 4; ++ks) aq[ks] = *(const bf16x8*)(QH + (it * 16 + fr) * 136 + ks * 32 + fq * 8);
#pragma unroll
        for (int mm = 0; mm < 2; ++mm) { const int mt = mt0 + mm; f32x4 acc = {0.f, 0.f, 0.f, 0.f};
#pragma unroll
            for (int ks = 0; ks < 4; ++ks) { const bf16x8 bk = *(const bf16x8*)(KH + (mt * 16 + fr) * 136 + ks * 32 + fq * 8); acc = __builtin_amdgcn_mfma_f32_16x16x32_bf16(aq[ks], bk, acc, 0, 0, 0); }
            const int m = mt * 16 + fr;
#pragma unroll
            for (int r = 0; r < 4; ++r) { const int n = it * 16 + fq * 4 + r; const bool keep = dir ? (m >= n) : (m <= n); P[n * 72 + m] = (bf16_t)(cvtpk(keep ? acc[r] : 0.f, 0.f) & 0xffffu); } }
        __syncthreads();
        bf16x8 ap[2];
#pragma unroll
        for (int ks = 0; ks < 2; ++ks) ap[ks] = *(const bf16x8*)(P + (it * 16 + fr) * 72 + ks * 32 + fq * 8);
#pragma unroll
        for (int j = 0; j < 4; ++j) { const int et = et0 + j;
#pragma unroll
            for (int ks = 0; ks < 2; ++ks) { const bf16x8 bv = *(const bf16x8*)(VT + (et * 16 + fr) * 72 + ks * 32 + fq * 8); oacc[j] = __builtin_amdgcn_mfma_f32_16x16x32_bf16(ap[ks], bv, oacc[j], 0, 0, 0); }
#pragma unroll
            for (int ks = 0; ks < 4; ++ks) { const bf16x8 bs = *(const bf16x8*)(SL + (et * 16 + fr) * 136 + ks * 32 + fq * 8); oacc[j] = __builtin_amdgcn_mfma_f32_16x16x32_bf16(aq[ks], bs, oacc[j], 0, 0, 0); } }
        __syncthreads();
    }
#pragma unroll
    for (int j = 0; j < 4; ++j)
#pragma unroll
        for (int r = 0; r < 4; ++r) OS[(it * 16 + fq * 4 + r) * 132 + (et0 + j) * 16 + fr] = oacc[j][r];
    __syncthreads();
#pragma unroll
    for (int k = 0; k < 2; ++k) {
        const int idx = tid + 512 * k, n = idx >> 4, e0 = (idx & 15) * 8; const float* op = OS + n * 132 + e0; float o[8]; float ss = 0.f;
#pragma unroll
        for (int e = 0; e < 8; ++e) { o[e] = op[e]; ss += o[e] * o[e]; }
        ss = row16_sum(ss);
        const float rstd = rsqrtf(ss * (1.f / 128.f) + EPS);
        const unsigned gw_[4] = {rg[k].x, rg[k].y, rg[k].z, rg[k].w}; unsigned ow[4];
#pragma unroll
        for (int e2 = 0; e2 < 4; ++e2) { const float ga = __uint_as_float(gw_[e2] << 16), gb = __uint_as_float(gw_[e2] & 0xffff0000u);
            const float va = o[2 * e2] * rstd * onorm_g[e0 + 2 * e2] * (ga * __builtin_amdgcn_rcpf(1.0f + __expf(-ga))), vb = o[2 * e2 + 1] * rstd * onorm_g[e0 + 2 * e2 + 1] * (gb * __builtin_amdgcn_rcpf(1.0f + __expf(-gb)));
            ow[e2] = cvtpk(va, vb); }
        *(u32x4*)(MIX + (size_t)(row0 + n) * DM + 512 + h * 128 + e0) = (u32x4){ow[0], ow[1], ow[2], ow[3]};
    }
}

struct QKRow { u32x2 a[3][2]; };
__device__ __forceinline__ void qk_load4(QKRow (&R)[4], int row0, const bf16_t* Z1, int loff) {
#pragma unroll
    for (int r4 = 0; r4 < 4; ++r4) { const bf16_t* zp = Z1 + (size_t)(row0 + r4) * ATTIN + loff;
#pragma unroll
        for (int ps = 0; ps < 3; ++ps) { R[r4].a[ps][0] = *(const u32x2*)(zp + ps * 512); R[r4].a[ps][1] = *(const u32x2*)(zp + ps * 512 + 32); } }
}
__device__ __forceinline__ void qk_finish4(const QKRow (&R)[4], int row0, int g, int half, int doff, const float (&inv4)[4], const float (&gq)[8], const float (&gk)[8], bf16_t* Qc, bf16_t* Kc, bf16_t* Vc) {
#pragma unroll
    for (int r4 = 0; r4 < 4; ++r4) { const int row = row0 + r4; const int b = row / ROWS_B, p = row - b * ROWS_B; const bool isctx = p >= SEQL;
        float sn[4], cs[4];
#pragma unroll
        for (int t = 0; t < 4; ++t) { sn[t] = 0.f; cs[t] = 1.f; }
        if (!isctx) { const float pos = (float)(half ? (p & 63) : (p >> 6));
#pragma unroll
            for (int t = 0; t < 4; ++t) { float rev = pos * inv4[t]; rev -= rintf(rev); sn[t] = __builtin_amdgcn_sinf(rev); cs[t] = __builtin_amdgcn_cosf(rev); } }
#pragma unroll
        for (int ps = 0; ps < 3; ++ps) {
            if (ps < 2 && isctx) continue;
            const u32x2 w1 = R[r4].a[ps][0], w2 = R[r4].a[ps][1];
            float x1[4] = {__uint_as_float(w1.x << 16), __uint_as_float(w1.x & 0xffff0000u), __uint_as_float(w1.y << 16), __uint_as_float(w1.y & 0xffff0000u)};
            float x2[4] = {__uint_as_float(w2.x << 16), __uint_as_float(w2.x & 0xffff0000u), __uint_as_float(w2.y << 16), __uint_as_float(w2.y & 0xffff0000u)};
            float ss = (x1[0] * x1[0] + x1[1] * x1[1]) + (x1[2] * x1[2] + x1[3] * x1[3]) + (x2[0] * x2[0] + x2[1] * x2[1]) + (x2[2] * x2[2] + x2[3] * x2[3]);
            ss = row16_sum(ss);
            const float rstd = rsqrtf(ss * (1.f / 128.f) + EPS);
            u32x2 o1, o2;
            { float y1[4], y2[4];
#pragma unroll
              for (int t = 0; t < 4; ++t) { const float a1 = x1[t] * rstd * (ps < 2 ? gq[t] : gk[t]), a2 = x2[t] * rstd * (ps < 2 ? gq[4 + t] : gk[4 + t]);
                  y1[t] = a1 * cs[t] - a2 * sn[t]; y2[t] = a2 * cs[t] + a1 * sn[t]; }
              o1.x = pk2(y1[0], y1[1]); o1.y = pk2(y1[2], y1[3]); o2.x = pk2(y2[0], y2[1]); o2.y = pk2(y2[2], y2[3]); }
            bf16_t* dst;
            if (ps < 2) dst = Qc + ((size_t)(b * 8 + ps * 4 + g) * SEQL + p) * 128;
            else if (g < 2) dst = Kc + ((size_t)(b * 2 + g) * ROWS_B + p) * 128;
            else { dst = Vc + ((size_t)(b * 2 + (g - 2)) * ROWS_B + p) * 128; o1 = w1; o2 = w2; }
            *(u32x2*)(dst + doff) = o1; *(u32x2*)(dst + doff + 32) = o2;
        }
    }
}
__device__ __forceinline__ void qknorm_rope(int gw, int NGW, int lane, int rmode  , const bf16_t* Z1, const float* qn_g, const float* kn_g, bf16_t* Qc, bf16_t* Kc, bf16_t* Vc) {
    const int g = lane >> 4, sub = lane & 15, half = sub >> 3, i0 = (sub & 7) * 4, doff = half * 64 + i0, loff = g * 128 + doff;
    float inv4[4], gq[8], gk[8];
#pragma unroll
    for (int t = 0; t < 4; ++t) { inv4[t] = exp2f(-(float)(i0 + t) * (13.287712379549449f / 32.f)) * 0.15915494309189535f;
        gq[t] = qn_g[doff + t]; gq[4 + t] = qn_g[doff + 32 + t]; gk[t] = kn_g[doff + t]; gk[4 + t] = kn_g[doff + 32 + t]; }
#define QK_ON(r0) ((((r0) % ROWS_B) >= SEQL) == (rmode == 2))
    int row0 = gw * 4; const int step = NGW * 4;
    if (row0 >= MROWS) return;
    QKRow A[4], B[4];
    if (QK_ON(row0)) qk_load4(A, row0, Z1, loff);
    for (;;) {
        int n0 = row0 + step; bool more = n0 < MROWS;
        if (more && QK_ON(n0)) qk_load4(B, n0, Z1, loff);
        if (QK_ON(row0)) qk_finish4(A, row0, g, half, doff, inv4, gq, gk, Qc, Kc, Vc);
        if (!more) break;
        row0 = n0; n0 = row0 + step; more = n0 < MROWS;
        if (more && QK_ON(n0)) qk_load4(A, n0, Z1, loff);
        if (QK_ON(row0)) qk_finish4(B, row0, g, half, doff, inv4, gq, gk, Qc, Kc, Vc);
        if (!more) break;
        row0 = n0;
    }
#undef QK_ON
}
}
#define LAS __attribute__((address_space(3)))
#define XB_TMO      128
#define XB_XCNT(j)  (256  + 64 * (j))
#define XB_XSUB(j)  (1280 + 64 * (j))
#define XB_XGEN(j)  (2304 + 64 * (j))
#define XB_TOP      3328
#define XB_TOPGEN   3392
#define XCD_BAR_WORDS 3456
#define XB_SPIN_CAP (1u << 18)

__device__ __forceinline__ unsigned xb_ld(unsigned* p)              { return __hip_atomic_load(p, __ATOMIC_RELAXED, __HIP_MEMORY_SCOPE_AGENT); }
__device__ __forceinline__ unsigned xb_add(unsigned* p, unsigned v) { return __hip_atomic_fetch_add(p, v, __ATOMIC_RELAXED, __HIP_MEMORY_SCOPE_AGENT); }
__device__ __forceinline__ unsigned xb_xcc_id() { return (unsigned)__builtin_amdgcn_s_getreg((3 << 11) | 20) & 0xFu; }
#define XB_SPIN(cond, bar) do { unsigned _sp = 0; while (cond) { __builtin_amdgcn_s_sleep(1); \
    if ((++_sp & 255u) == 0u) { if (xb_ld(&(bar)[XB_TMO])) break; if (_sp > XB_SPIN_CAP) { atomicAdd(&(bar)[XB_TMO], 1u); break; } } } } while (0)

struct XcdBarrier {
    unsigned* bar; unsigned x;
    volatile LAS unsigned* st;
};

__device__ __forceinline__ XcdBarrier xcd_barrier_post(unsigned* bar, volatile LAS unsigned* st) {
    XcdBarrier b; b.bar = bar; b.x = xb_xcc_id(); b.st = st;
    if (threadIdx.x == 0) (void)xb_add(&bar[XB_XCNT(b.x)], 1u);
    return b;
}
__device__ __forceinline__ void xcd_barrier_complete(unsigned* bar, unsigned x, unsigned& nloc, unsigned& nx) {
    const unsigned G = gridDim.x * gridDim.y * gridDim.z;
    unsigned sum, cnt, mine, sp = 0u;
    for (;;) {
        sum = 0u; cnt = 0u; mine = 0u;
#pragma unroll
        for (unsigned j = 0; j < 16; ++j) { const unsigned c = xb_ld(&bar[XB_XCNT(j)]); sum += c; cnt += (c > 0u) ? 1u : 0u; mine = (j == x) ? c : mine; }
        if (sum == G) break;
        __builtin_amdgcn_s_sleep(1);
        if ((++sp & 255u) == 0u) { if (xb_ld(&bar[XB_TMO])) break; if (sp > XB_SPIN_CAP) { atomicAdd(&bar[XB_TMO], 1u); break; } }
    }
    nloc = mine > 0u ? mine : 1u; nx = cnt > 0u ? cnt : 1u;
}

__device__ __forceinline__ void xcd_barrier(const XcdBarrier& b) {
    asm volatile("s_waitcnt vmcnt(0)" ::: "memory");
    __syncthreads();
    if (threadIdx.x == 0) {
        unsigned* bar = b.bar;
        __builtin_amdgcn_s_waitcnt(0);
        unsigned nloc = b.st[0], nx = b.st[1];
        if (nloc == 0u) { xcd_barrier_complete(bar, b.x, nloc, nx); b.st[0] = nloc; b.st[1] = nx; }
        const unsigned old = xb_add(&bar[XB_XSUB(b.x)], 1u);
        const unsigned gen = old / nloc;
        if (old + 1u == (gen + 1u) * nloc) {
            __builtin_amdgcn_fence(__ATOMIC_RELEASE, "agent");
            asm volatile("s_waitcnt vmcnt(0)" ::: "memory");
            const unsigned og = xb_add(&bar[XB_TOP], 1u);
            const unsigned tg = og / nx;
            if (og + 1u == (tg + 1u) * nx) xb_add(&bar[XB_TOPGEN], 1u);
            else XB_SPIN(xb_ld(&bar[XB_TOPGEN]) == tg, bar);
            __builtin_amdgcn_fence(__ATOMIC_ACQUIRE, "agent");
            xb_add(&bar[XB_XGEN(b.x)], 1u);
            asm volatile("s_waitcnt vmcnt(0)" ::: "memory");
        } else {
            XB_SPIN(xb_ld(&bar[XB_XGEN(b.x)]) == gen, bar);
            __builtin_amdgcn_fence(__ATOMIC_ACQUIRE, "agent");
            asm volatile("s_waitcnt vmcnt(0)" ::: "memory");
        }
    }
    __syncthreads();
}


#ifndef MK_N_LAUNCHES
#define MK_N_LAUNCHES 1
#endif
struct Args { const float* in[19]; float* out; unsigned char* ws; int ph_lo, ph_hi; };

__global__ void __launch_bounds__(mk::NTHR, 2) fwd_kernel(Args args) {
    using namespace mk;
    extern __shared__ __attribute__((aligned(16))) unsigned char lds[];
    cg::grid_group grid = cg::this_grid();
    const int tid = threadIdx.x, lane = tid & 63, wave = __builtin_amdgcn_readfirstlane(tid >> 6);
    const int G = gridDim.x, bx = blockIdx.x; const int vcu = (G % 8 == 0) ? (bx % 8) * (G / 8) + bx / 8 : bx;
    const int gw = vcu * NWAVES + wave, NGW = G * NWAVES;
    unsigned char* ws = args.ws;
    const float* x = args.in[0]; const float* cvec = args.in[1]; const float* ctx = args.in[2]; const float* c_ctx = args.in[3];
    const float* ada_w = args.in[4]; const float* ada_b = args.in[5]; const float* norm_g = args.in[6];
    const float* ab_w_in = args.in[7]; const float* ab_w_out = args.in[8]; const float* pool_w = args.in[9]; const float* pool_scale = args.in[10];
    const float* hg_lower = args.in[11]; const float* hg_onorm_g = args.in[12];
    const float* att_w_in = args.in[13]; const float* att_w_out = args.in[14]; const float* qn_g = args.in[15]; const float* kn_g = args.in[16];
    const float* ffn_w_in = args.in[17]; const float* ffn_w_out = args.in[18];
    float* out = args.out;
    float* mods = (float*)(ws + WS_MODS);
    bf16_t* W_ABIN = (bf16_t*)(ws + WS_W_ABIN); bf16_t* W_ABOUT = (bf16_t*)(ws + WS_W_ABOUT); bf16_t* W_ATTIN = (bf16_t*)(ws + WS_W_ATTIN); bf16_t* W_ATTOUT = (bf16_t*)(ws + WS_W_ATTOUT);
    bf16_t* W_FFIN = (bf16_t*)(ws + WS_W_FFIN); bf16_t* W_FFOUT = (bf16_t*)(ws + WS_W_FFOUT); bf16_t* PWT = (bf16_t*)(ws + WS_POOLWT);
    float* DEC = (float*)(ws + WS_DEC); float* CTXS = (float*)(ws + WS_CTXS);
    bf16_t* XN = (bf16_t*)(ws + WS_XN); bf16_t* Y = (bf16_t*)(ws + WS_Y); bf16_t* SB = (bf16_t*)(ws + WS_SB); bf16_t* Z = (bf16_t*)(ws + WS_Z); bf16_t* MIX = (bf16_t*)(ws + WS_MIX);
    bf16_t* H = Z; bf16_t* Z1 = Z; bf16_t* UU = Z; bf16_t* ZH = Z + (size_t)MROWS * 512; bf16_t* Qc = (bf16_t*)(ws + WS_QC); bf16_t* Kc = (bf16_t*)(ws + WS_KC); bf16_t* Vc = (bf16_t*)(ws + WS_VC);
    PG8_LAS unsigned char* ldsl = (PG8_LAS unsigned char*)lds;
    const int lo = args.ph_lo, hi = args.ph_hi;
    volatile LAS unsigned* bst = (volatile LAS unsigned*)((LAS unsigned char*)lds + (LDS_BYTES - 64));
    if (tid < 2) bst[tid] = 0u;
    __syncthreads();
    XcdBarrier xbar = xcd_barrier_post((unsigned*)(ws + WS_CTL) + 4096, bst);
#define IN(k) (lo <= (k) && (k) < hi)
#define SEAM(k) do { if (IN(k) && IN((k) + 1)) { if (hi < 0) { asm volatile("s_waitcnt vmcnt(0)" ::: "memory"); grid.sync(); } else xcd_barrier(xbar); } } while (0)

    if (IN(0)) {
        float* scr = (float*)(lds + wave * 16384);
        constexpr int I_ADA = 2 * 96 * 16;
        constexpr int I1 = 16 * 96, I2 = 16 * 32, I3 = 16 * 48, I4 = 16 * 32, I5 = 16 * 176, I6 = 44 * 32, I7 = 8;
        constexpr int NIT = I_ADA + I1 + I2 + I3 + I4 + 2 * I5 + 2 * I6 + 4 * I7;
        for (int it = gw; it < NIT; it += NGW) {
            int r = it;
            if (r < I_ADA) { ada_item(r, cvec, c_ctx, ada_w, ada_b, mods, lane); continue; } r -= I_ADA;
            if (r < I1) { transpose_abin(ab_w_in, W_ABIN, r, scr, lane); continue; } r -= I1;
            if (r < I2) { transpose_plain(ab_w_out, DM, DM, W_ABOUT, r, scr, lane); continue; } r -= I2;
            if (r < I3) { transpose_plain(att_w_in, DM, ATTIN, W_ATTIN, r, scr, lane); continue; } r -= I3;
            if (r < I4) { transpose_plain(att_w_out, DM, DM, W_ATTOUT, r, scr, lane); continue; } r -= I4;
            if (r < 2 * I5) { const int l = r / I5; transpose_ffin(ffn_w_in + (size_t)l * DM * FFIN, W_FFIN + (size_t)l * FFIN * DM, r - l * I5, scr, lane); continue; } r -= 2 * I5;
            if (r < 2 * I6) { const int l = r / I6; transpose_plain(ffn_w_out + (size_t)l * FFH * DM, FFH, DM, W_FFOUT + (size_t)l * DM * FFH, r - l * I6, scr, lane); continue; } r -= 2 * I6;
            { const int g = r / I7; transpose_plain(pool_w + (size_t)g * 16384, 128, 128, PWT + (size_t)g * 16384, r - g * I7, scr, lane); }
        }
    }
    SEAM(0);
    if (IN(1)) row_phase<false, false, true>(gw, NGW, lane, tid, (float*)lds, 0, x, ctx, nullptr, nullptr, nullptr, nullptr, 0, nullptr, norm_g + 0 * DM, mods, 0, 1, XN);
    SEAM(1);
    if (IN(2)) { pg8::Gemm g{XN, W_ABIN, MROWS, ABIN, DM}; pg8::StaticOrder S; S.init(MROWS, ABIN, G, bx); pg8::EpiZ E{UU, ZH, MROWS};
        pg8::gemm_phase<pg8::EpiZ, pg8::StaticOrder, true, true>(ldsl, g, S, E); }
    SEAM(2);
    if (IN(3)) { u32x4 pzf[2], pzb[2], pv[2]; if (vcu < NTASK_C) hgrn_a_load(vcu, ZH, pzf, pzb, pv, tid);
        for (int t = vcu; t < NTASK_C + NTASK_POOL; t += G) { if (t < NTASK_C) hgrn_a_task(t, (t + G < NTASK_C) ? t + G : -1, pzf, pzb, pv, ZH, hg_lower, SB, DEC, (char*)lds, tid); else pool_task(t - NTASK_C, UU, PWT, pool_scale, MIX, (char*)lds, tid); } }
    SEAM(3);
    if (IN(4)) hgrn_b(vcu, G, tid, SB, DEC);
    SEAM(4);
    if (IN(5)) { u32x4 pq[2], pzf[2], pv[2]; if (vcu < NTASK_C) hgrn_c_load(vcu, ZH, pq, pzf, pv, tid);
        for (int t = vcu; t < NTASK_C; t += G) hgrn_c_task(t, (t + G < NTASK_C) ? t + G : -1, pq, pzf, pv, ZH, hg_lower, hg_onorm_g, SB, MIX, (char*)lds, tid);
        __syncthreads(); }
    SEAM(5);
    if (IN(6)) { pg8::Gemm g{MIX, W_ABOUT, MROWS, DM, DM}; pg8::LatOrder S; S.init(MLAT, DM, G, bx); pg8::EpiStoreBf16 E{Y, DM};
        pg8::gemm_phase<pg8::EpiStoreBf16, pg8::LatOrder, true, true>(ldsl, g, S, E); }
    SEAM(6);
    if (IN(7)) {
        if (bx < 16) { pg8::Gemm g{MIX, W_ABOUT, MROWS, DM, DM}; pg8::CtxOrder S{bx}; pg8::EpiStoreBf16 E{Y, DM};
            pg8::gemm_phase<pg8::EpiStoreBf16, pg8::CtxOrder, true, true>(ldsl, g, S, E); }
        else row_phase<true, true, true>((bx - 16) * NWAVES + wave, (G - 16) * NWAVES, lane, tid, (float*)lds, 1, x, ctx, out, CTXS, Y, mods, 2, norm_g + 1 * DM, norm_g + 2 * DM, mods, 3, 4, XN);
        xcd_barrier(xbar);
        row_phase<true, true, true>(gw, NGW, lane, tid, (float*)lds, 2, x, ctx, out, CTXS, Y, mods, 2, norm_g + 1 * DM, norm_g + 2 * DM, mods, 3, 4, XN);
    }
    SEAM(7);
    if (IN(8)) { pg8::Gemm g{XN, W_FFIN, MROWS, FFIN, DM}; pg8::StaticOrder S; S.init(MROWS, FFIN, G, bx); pg8::EpiSwiglu E{H, FFH};
        pg8::gemm_phase<pg8::EpiSwiglu, pg8::StaticOrder, true, true>(ldsl, g, S, E); }
    SEAM(8);
    if (IN(9)) { pg8::Gemm g{H, W_FFOUT, MROWS, DM, FFH}; pg8::LatOrder S; S.init(MLAT, DM, G, bx); pg8::EpiStoreBf16 E{Y, DM};
        pg8::gemm_phase<pg8::EpiStoreBf16, pg8::LatOrder, true, true>(ldsl, g, S, E); }
    SEAM(9);
    if (IN(10)) {
        if (bx < 16) { pg8::Gemm g{H, W_FFOUT, MROWS, DM, FFH}; pg8::CtxOrder S{bx}; pg8::EpiStoreBf16 E{Y, DM};
            pg8::gemm_phase<pg8::EpiStoreBf16, pg8::CtxOrder, true, true>(ldsl, g, S, E); }
        else row_phase<true, true, true>((bx - 16) * NWAVES + wave, (G - 16) * NWAVES, lane, tid, (float*)lds, 1, out, CTXS, out, CTXS, Y, mods, 5, norm_g + 3 * DM, norm_g + 4 * DM, mods + 5 * 6144, 0, 1, XN);
        xcd_barrier(xbar);
        row_phase<true, true, true>(gw, NGW, lane, tid, (float*)lds, 2, out, CTXS, out, CTXS, Y, mods, 5, norm_g + 3 * DM, norm_g + 4 * DM, mods + 5 * 6144, 0, 1, XN);
    }
    SEAM(10);
    if (IN(11)) { pg8::Gemm g{XN, W_ATTIN, MROWS, ATTIN, DM}; pg8::LatOrder S; S.init(MLAT, ATTIN, G, bx); pg8::EpiStoreBf16 E{Z1, ATTIN};
        pg8::gemm_phase<pg8::EpiStoreBf16, pg8::LatOrder, true, true>(ldsl, g, S, E); }
    SEAM(11);
    if (IN(12)) {
        if (bx < 8) { pg8::Gemm g{XN, W_ATTIN, MROWS, ATTIN, DM}; pg8::CtxKvOrder S{bx}; pg8::EpiStoreBf16 E{Z1, ATTIN};
            pg8::gemm_phase<pg8::EpiStoreBf16, pg8::CtxKvOrder, true, true>(ldsl, g, S, E); }
        else qknorm_rope((bx - 8) * NWAVES + wave, (G - 8) * NWAVES, lane, 1, Z1, qn_g, kn_g, Qc, Kc, Vc);
        xcd_barrier(xbar);
        qknorm_rope(gw, NGW, lane, 2, Z1, qn_g, kn_g, Qc, Kc, Vc);
    }
    SEAM(12);
    if (IN(13)) {
        for (int u = vcu; u < 1024; u += G) { const int qb = u & 31, gq = (u >> 5) & 3, kvh = (u >> 7) & 1, b = u >> 8, h = kvh * 4 + gq;
            attn::attn_dense_body<attn::bf16>((const attn::bf16*)(Qc + ((size_t)(b * 8 + h) * SEQL + qb * 256) * 128), (const attn::bf16*)(Kc + (size_t)(b * 2 + kvh) * ROWS_B * 128),
                                              (const attn::bf16*)(Vc + (size_t)(b * 2 + kvh) * ROWS_B * 128), MIX + ((size_t)b * ROWS_B + qb * 256) * DM + h * 128, ROWS_B, (char*)lds);
            __syncthreads(); }
    }
    SEAM(13);
    if (IN(14)) { pg8::Gemm g{MIX, W_ATTOUT, MROWS, DM, DM}; pg8::LatOrder S; S.init(MLAT, DM, G, bx); pg8::EpiStoreBf16 E{Y, DM};
        pg8::gemm_phase<pg8::EpiStoreBf16, pg8::LatOrder, true, true>(ldsl, g, S, E); }
    SEAM(14);
    if (IN(15)) row_phase<true, true, true>(gw, NGW, lane, tid, (float*)lds, 1, out, CTXS, out, CTXS, Y, mods + 5 * 6144, 2, norm_g + 5 * DM, norm_g + 6 * DM, mods + 5 * 6144, 3, 4, XN);
    SEAM(15);
    if (IN(16)) { pg8::Gemm g{XN, W_FFIN + (size_t)FFIN * DM, MROWS, FFIN, DM}; pg8::LatOrder S; S.init(MLAT, FFIN, G, bx); pg8::EpiSwiglu E{H, FFH};
        pg8::gemm_phase<pg8::EpiSwiglu, pg8::LatOrder, true, true>(ldsl, g, S, E); }
    SEAM(16);
    if (IN(17)) { pg8::Gemm g{H, W_FFOUT + (size_t)DM * FFH, MROWS, DM, FFH}; pg8::LatOrder S; S.init(MLAT, DM, G, bx); pg8::EpiStoreBf16 E{Y, DM};
        pg8::gemm_phase<pg8::EpiStoreBf16, pg8::LatOrder, true, true>(ldsl, g, S, E); }
    SEAM(17);
    if (IN(18)) row_phase<true, true, false>(gw, NGW, lane, tid, (float*)lds, 1, out, CTXS, out, CTXS, Y, mods + 5 * 6144, 5, norm_g + 7 * DM, nullptr, nullptr, 0, 0, nullptr);
#undef IN
#undef SEAM
}

extern "C" void kernel_launch(void* const* d_in, const int* in_sizes, int n_in, void* d_out, int out_size, void* d_ws, size_t ws_size, hipStream_t stream) {
    using namespace mk;
    static int grid = 0;
    if (grid == 0) {
        if (n_in != 19 || in_sizes[0] != MLAT * DM || out_size != MLAT * DM || ws_size < WS_END) { fprintf(stderr, "kernel_launch: unexpected shapes (n_in %d, in0 %d, out %d, ws %zu)\n", n_in, n_in > 0 ? in_sizes[0] : -1, out_size, ws_size); grid = -1; return; }
        int dev = 0, cus = 0, per_cu = 0;
        if (hipGetDevice(&dev) != hipSuccess || hipDeviceGetAttribute(&cus, hipDeviceAttributeMultiprocessorCount, dev) != hipSuccess) { grid = -1; return; }
        if (hipFuncSetAttribute((const void*)fwd_kernel, hipFuncAttributeMaxDynamicSharedMemorySize, LDS_BYTES) != hipSuccess) { fprintf(stderr, "kernel_launch: hipFuncSetAttribute failed\n"); grid = -1; return; }
        if (hipOccupancyMaxActiveBlocksPerMultiprocessor(&per_cu, (const void*)fwd_kernel, NTHR, LDS_BYTES) != hipSuccess || per_cu < 1) { fprintf(stderr, "kernel_launch: occupancy query says %d\n", per_cu); per_cu = 1; }
        (void)hipGetLastError();
        grid = cus;
    }
    if (grid < 0) return;
    (void)hipMemsetAsync((char*)d_ws + WS_CTL, 0, CTL_ZERO_BYTES, stream);
    Args a{};
    for (int i = 0; i < 19; ++i) a.in[i] = (const float*)d_in[i];
    a.out = (float*)d_out; a.ws = (unsigned char*)d_ws;
#if MK_N_LAUNCHES == 1
    a.ph_lo = 0; a.ph_hi = N_PHASES;
    void* kargs[] = {&a};
    hipError_t e = hipLaunchCooperativeKernel((const void*)fwd_kernel, dim3(grid), dim3(NTHR), kargs, LDS_BYTES, stream);
    if (e != hipSuccess) fprintf(stderr, "kernel_launch: cooperative launch failed: %s (grid %d)\n", hipGetErrorString(e), grid);
#else
    for (int ph = 0; ph < N_PHASES; ++ph) { a.ph_lo = ph; a.ph_hi = ph + 1; hipLaunchKernelGGL(fwd_kernel, dim3(grid), dim3(NTHR), LDS_BYTES, stream, a); }
#endif
}
```

```cpp
#include <hip/hip_runtime.h>
#include <hip/hip_cooperative_groups.h>
#include <hip/hip_bf16.h>
#include <cstdio>
#include <cstdint>
#include <cmath>
namespace cg = cooperative_groups;
namespace pg8 {
#define PG8_LAS __attribute__((address_space(3)))
typedef unsigned short bf16_t;
typedef short bf16x8 __attribute__((ext_vector_type(8)));
typedef float f32x4 __attribute__((ext_vector_type(4)));
typedef unsigned u32x4 __attribute__((ext_vector_type(4)));
constexpr int BM = 256, BK = 64, HALF = 128, HTB = HALF * BK * 2  , STAGE_BYTES = 8 * HTB, NXCD = 8, WGM = 8;

__host__ __device__ __forceinline__ int lds_byte(int r, int c) { const int st = (r >> 4) * 2 + (c >> 5), rr = r & 15, cc = c & 31, ob = rr * 64 + cc * 2; return st * 1024 + (ob ^ (((ob >> 9) & 1) << 5)); }
__host__ __device__ __forceinline__ void stage_rc(int b, int& R, int& C) { const int st = b / 1024, sb = b % 1024, swz = sb ^ (((sb >> 9) & 1) << 5); R = (st >> 1) * 16 + swz / 64; C = (st & 1) * 32 + (swz % 64) / 2; }
__host__ __device__ __forceinline__ int perm32(int rho) { const int n = rho >> 4, i = rho & 15; return 8 * (i >> 2) + 4 * n + (i & 3); }

struct Unit { int pm, pn; };
struct Gemm { const bf16_t* A; const bf16_t* Bt; int M, N, K; };

struct StaticOrder {
    int nM, nN, nwg, G, c;
    __host__ __device__ void init(int M, int N, int G_, int c_) { nM = M / BM; nN = N / BM; nwg = nM * nN; G = G_; c = c_; }
    __host__ __device__ bool next(int i, Unit& u) const {
        const long L = (long)i * G + c; if (L >= nwg) return false;
        int wgid = (int)L; { const int q = nwg / NXCD, r = nwg % NXCD, xcd = wgid % NXCD, off = wgid / NXCD; wgid = (xcd < r ? xcd * (q + 1) : r * (q + 1) + (xcd - r) * q) + off; }
        const int nig = WGM * nN, gid = wgid / nig, fm = gid * WGM, gsz = (nM - fm) < WGM ? (nM - fm) : WGM;
        u.pm = fm + ((wgid % nig) % gsz); u.pn = (wgid % nig) / gsz; return true;
    }
    __device__ __forceinline__ void a_ready(const Unit&) const {}
    __device__ __forceinline__ void done(const Unit&) const {}
};

__device__ __forceinline__ unsigned cvt_pk_bf16(float lo, float hi) { unsigned r; asm volatile("v_cvt_pk_bf16_f32 %0, %1, %2" : "=v"(r) : "v"(lo), "v"(hi)); return r; }
template <class Epi, class Sched, bool ALIGN_EPI = false, bool SP2 = false>
__device__ __forceinline__ void gemm_phase(PG8_LAS unsigned char* lds, const Gemm g, const Sched& S, const Epi& E) {
    const int tid = threadIdx.x, wid = __builtin_amdgcn_readfirstlane(tid >> 6), lane = tid & 63, wr = wid >> 2, wc = wid & 3, fr = lane & 15, fq = lane >> 4;
    const int K = g.K, nt = K / BK;
    unsigned voffA[2], voffB[2];
#pragma unroll
    for (int i = 0; i < 2; ++i) { int R, C; stage_rc(tid * 16 + i * 8192, R, C); const int Rb = Epi::PERM ? ((R & ~31) + perm32(R & 31)) : R;
        voffA[i] = (unsigned)(R * K + C) * 2u; voffB[i] = (unsigned)(Rb * K + C) * 2u; }
    const size_t kstep = (size_t)(BK * 2);
    const size_t hstep = (size_t)HALF * K * 2;
    const size_t tstep = 2 * hstep;
    const unsigned ldsw = (unsigned)wid * 1024u;
    const int aoff = lds_byte(wr * 64 + fr, fq * 8), boff = lds_byte(wc * 32 + fr, fq * 8);
#define PG8_SA(b, h) (((b) * 2 + (h)) * HTB)
#define PG8_SB(b, h) ((4 + (b) * 2 + (h)) * HTB)
#define PG8_STAGE(bufoff, gbase, voff) do { _Pragma("unroll") for (int _i = 0; _i < 2; ++_i) \
        __builtin_amdgcn_global_load_lds((const unsigned*)((const char*)(gbase) + (voff)[_i]), (PG8_LAS unsigned*)(lds + (bufoff) + ldsw + _i * 8192), 16, 0, 0); } while (0)
#define PG8_LDA(dst, b, h) do { _Pragma("unroll") for (int m = 0; m < 4; ++m) _Pragma("unroll") for (int k = 0; k < 2; ++k) dst[m][k] = *(const PG8_LAS bf16x8*)(lds + PG8_SA(b, h) + aoff + m * 2048 + k * 1024); } while (0)
#define PG8_LDB(dst, b, h) do { _Pragma("unroll") for (int n = 0; n < 2; ++n) _Pragma("unroll") for (int k = 0; k < 2; ++k) dst[n][k] = *(const PG8_LAS bf16x8*)(lds + PG8_SB(b, h) + boff + n * 2048 + k * 1024); } while (0)
#define PG8_MMA(ai, bj, At, Bt) do { __builtin_amdgcn_s_setprio(1); _Pragma("unroll") for (int m = 0; m < 4; ++m) _Pragma("unroll") for (int n = 0; n < 2; ++n) _Pragma("unroll") for (int k = 0; k < 2; ++k) \
        acc[ai][bj][m][n] = __builtin_amdgcn_mfma_f32_16x16x32_bf16(Bt[n][k], At[m][k], acc[ai][bj][m][n], 0, 0, 0); __builtin_amdgcn_s_setprio(0); } while (0)
#define PG8_WAIT_V(n) asm volatile("s_waitcnt vmcnt(" #n ")" ::: "memory")
#define PG8_WAIT_L(n) asm volatile("s_waitcnt lgkmcnt(" #n ")" ::: "memory")
#define PG8_BAR __builtin_amdgcn_s_barrier()
#define PG8_SCHED __builtin_amdgcn_sched_barrier(0)
    Unit cur, nxt; int ui = 0;
    if (!S.next(0, cur)) return;
    f32x4 acc[2][2][4][2];
#pragma unroll
    for (int a = 0; a < 2; ++a)
#pragma unroll
        for (int b = 0; b < 2; ++b)
#pragma unroll
            for (int m = 0; m < 4; ++m)
#pragma unroll
                for (int n = 0; n < 2; ++n) acc[a][b][m][n] = (f32x4){0.f, 0.f, 0.f, 0.f};
    bf16x8 At[4][2], B0[2][2], B1[2][2];
    const char* cA = (const char*)g.A + (size_t)cur.pm * tstep; const char* cB = (const char*)g.Bt + (size_t)cur.pn * tstep;
    S.a_ready(cur);
    if constexpr (SP2) {
        PG8_STAGE(PG8_SB(0, 0), cB, voffB); PG8_STAGE(PG8_SB(0, 1), cB + hstep, voffB); PG8_STAGE(PG8_SA(0, 0), cA, voffA); PG8_STAGE(PG8_SA(0, 1), cA + hstep, voffA);
        if (wr == 1) PG8_BAR;
        PG8_WAIT_V(2); PG8_BAR;
        PG8_STAGE(PG8_SB(1, 0), cB + kstep, voffB); PG8_STAGE(PG8_SA(1, 0), cA + kstep, voffA); PG8_STAGE(PG8_SB(1, 1), cB + hstep + kstep, voffB);
        PG8_WAIT_V(6); PG8_BAR;
    } else {
        PG8_STAGE(PG8_SB(0, 0), cB, voffB); PG8_STAGE(PG8_SA(0, 0), cA, voffA); PG8_STAGE(PG8_SB(0, 1), cB + hstep, voffB); PG8_STAGE(PG8_SA(0, 1), cA + hstep, voffA);
        if (wr == 1) PG8_BAR;
        PG8_WAIT_V(4); PG8_BAR;
        PG8_STAGE(PG8_SB(1, 0), cB + kstep, voffB); PG8_STAGE(PG8_SA(1, 0), cA + kstep, voffA); PG8_STAGE(PG8_SB(1, 1), cB + hstep + kstep, voffB);
        PG8_WAIT_V(6); PG8_BAR;
    }
    for (;;) {
        const bool has_next = S.next(ui + 1, nxt);
        const char* nA = has_next ? (const char*)g.A + (size_t)nxt.pm * tstep : cA; const char* nB = has_next ? (const char*)g.Bt + (size_t)nxt.pn * tstep : cB;
        for (int t = 0; t < nt; t += 2) {
            const bool last = (t == nt - 2);
            const char* a1 = cA + (size_t)(t + 1) * kstep;
            const char* a2 = last ? nA : cA + (size_t)(t + 2) * kstep; const char* b2 = last ? nB : cB + (size_t)(t + 2) * kstep;
            const char* a3 = a2 + kstep; const char* b3 = b2 + kstep;
            if (last && has_next) S.a_ready(nxt);
            if constexpr (SP2) {
            PG8_LDB(B0, 0, 0); PG8_LDB(B1, 0, 1); PG8_SCHED; PG8_LDA(At, 0, 0); PG8_STAGE(PG8_SA(1, 1), a1 + hstep, voffA);
            PG8_WAIT_V(8); PG8_WAIT_L(0); PG8_BAR; PG8_MMA(0, 0, At, B0); PG8_MMA(0, 1, At, B1); PG8_BAR; PG8_SCHED;
            PG8_LDA(At, 0, 1); PG8_STAGE(PG8_SB(0, 0), b2, voffB); PG8_STAGE(PG8_SB(0, 1), b2 + hstep, voffB); PG8_STAGE(PG8_SA(0, 0), a2, voffA);
            PG8_WAIT_V(8); PG8_WAIT_L(0); PG8_BAR; PG8_MMA(1, 0, At, B0); PG8_MMA(1, 1, At, B1); PG8_BAR; PG8_SCHED;
            PG8_LDB(B0, 1, 0); PG8_LDB(B1, 1, 1); PG8_SCHED; PG8_LDA(At, 1, 0); PG8_STAGE(PG8_SA(0, 1), a2 + hstep, voffA);
            PG8_WAIT_V(8); PG8_WAIT_L(0); PG8_BAR; PG8_MMA(0, 0, At, B0); PG8_MMA(0, 1, At, B1); PG8_BAR; PG8_SCHED;
            PG8_LDA(At, 1, 1); PG8_STAGE(PG8_SB(1, 0), b3, voffB); PG8_STAGE(PG8_SB(1, 1), b3 + hstep, voffB); PG8_STAGE(PG8_SA(1, 0), a3, voffA);
            PG8_WAIT_V(8); PG8_WAIT_L(0); PG8_BAR; PG8_MMA(1, 0, At, B0); PG8_MMA(1, 1, At, B1); PG8_BAR; PG8_SCHED;
            } else {
            PG8_LDB(B0, 0, 0); PG8_SCHED; PG8_LDA(At, 0, 0); PG8_STAGE(PG8_SA(1, 1), a1 + hstep, voffA);
            PG8_WAIT_L(8); PG8_BAR; PG8_WAIT_L(0); PG8_MMA(0, 0, At, B0); PG8_BAR; PG8_SCHED;
            PG8_LDB(B1, 0, 1); PG8_STAGE(PG8_SB(0, 0), b2, voffB);
            PG8_BAR; PG8_WAIT_L(0); PG8_MMA(0, 1, At, B1); PG8_BAR;
            PG8_LDA(At, 0, 1); PG8_STAGE(PG8_SA(0, 0), a2, voffA);
            PG8_BAR; PG8_WAIT_L(0); PG8_MMA(1, 0, At, B0); PG8_BAR; PG8_SCHED;
            PG8_STAGE(PG8_SB(0, 1), b2 + hstep, voffB);
            PG8_WAIT_V(6); PG8_BAR; PG8_MMA(1, 1, At, B1); PG8_BAR;
            PG8_LDB(B0, 1, 0); PG8_SCHED; PG8_LDA(At, 1, 0); PG8_STAGE(PG8_SA(0, 1), a2 + hstep, voffA);
            PG8_WAIT_L(8); PG8_BAR; PG8_WAIT_L(0); PG8_MMA(0, 0, At, B0); PG8_BAR; PG8_SCHED;
            PG8_LDB(B1, 1, 1); PG8_STAGE(PG8_SB(1, 0), b3, voffB);
            PG8_BAR; PG8_WAIT_L(0); PG8_MMA(0, 1, At, B1); PG8_BAR;
            PG8_LDA(At, 1, 1); PG8_STAGE(PG8_SA(1, 0), a3, voffA);
            PG8_BAR; PG8_WAIT_L(0); PG8_MMA(1, 0, At, B0); PG8_BAR; PG8_SCHED;
            PG8_STAGE(PG8_SB(1, 1), b3 + hstep, voffB);
            PG8_WAIT_V(6); PG8_BAR; PG8_MMA(1, 1, At, B1); PG8_BAR;
            }
        }
        if constexpr (ALIGN_EPI) { if (wr == 0) PG8_BAR; }
        if constexpr (!Epi::AFTER_DRAIN) { E(acc, cur, wr, wc, fr, fq); S.done(cur); }
        if (!has_next) break;
#pragma unroll
        for (int a = 0; a < 2; ++a)
#pragma unroll
            for (int b = 0; b < 2; ++b)
#pragma unroll
                for (int m = 0; m < 4; ++m)
#pragma unroll
                    for (int n = 0; n < 2; ++n) acc[a][b][m][n] = (f32x4){0.f, 0.f, 0.f, 0.f};
        cur = nxt; cA = nA; cB = nB; ++ui;
        if constexpr (ALIGN_EPI) { if (wr == 1) PG8_BAR; }
    }
    PG8_WAIT_V(0);
    if constexpr (!ALIGN_EPI) { if (wr == 0) PG8_BAR; }
    PG8_BAR;
    if constexpr (Epi::AFTER_DRAIN) { E.fused(acc, cur, wr, wc, fr, fq, lds, wid, lane); S.done(cur); }
#undef PG8_SA
#undef PG8_SB
#undef PG8_STAGE
#undef PG8_LDA
#undef PG8_LDB
#undef PG8_MMA
#undef PG8_WAIT_V
#undef PG8_WAIT_L
#undef PG8_BAR
#undef PG8_SCHED
}
}
namespace pg8 {
struct EpiStoreBf16 {
    static constexpr bool PERM = true, AFTER_DRAIN = false;
    bf16_t* O; int ldc;
    __device__ __forceinline__ void operator()(const f32x4 (&acc)[2][2][4][2], const Unit& u, int wr, int wc, int fr, int fq) const {
        const int row0 = u.pm * BM + wr * 64 + fr, col0 = u.pn * BM + wc * 32 + 8 * fq;
#pragma unroll
        for (int ai = 0; ai < 2; ++ai)
#pragma unroll
            for (int m = 0; m < 4; ++m) { bf16_t* rowp = O + (size_t)(row0 + ai * HALF + m * 16) * ldc + col0;
#pragma unroll
                for (int bj = 0; bj < 2; ++bj) { const f32x4 v0 = acc[ai][bj][m][0], v1 = acc[ai][bj][m][1];
                    u32x4 w; w.x = cvt_pk_bf16(v0[0], v0[1]); w.y = cvt_pk_bf16(v0[2], v0[3]); w.z = cvt_pk_bf16(v1[0], v1[1]); w.w = cvt_pk_bf16(v1[2], v1[3]);
                    *(u32x4*)(rowp + bj * HALF) = w; } }
    }
};
struct EpiZ {
    static constexpr bool PERM = true, AFTER_DRAIN = false;
    bf16_t* U; bf16_t* ZH; int mrows;
    __device__ __forceinline__ void operator()(const f32x4 (&acc)[2][2][4][2], const Unit& u, int wr, int wc, int fr, int fq) const {
        const int row0 = u.pm * BM + wr * 64 + fr;
#pragma unroll
        for (int bj = 0; bj < 2; ++bj) { const int c = u.pn * BM + bj * HALF + wc * 32 + 8 * fq;
            bf16_t* base; size_t rstride;
            if (c < 512) { base = U + c; rstride = 512; } else { const int cp = c - 512, h = cp / 640, off = cp - h * 640; base = ZH + (size_t)h * mrows * 640 + off; rstride = 640; }
#pragma unroll
            for (int ai = 0; ai < 2; ++ai)
#pragma unroll
                for (int m = 0; m < 4; ++m) { const f32x4 v0 = acc[ai][bj][m][0], v1 = acc[ai][bj][m][1];
                    u32x4 w; w.x = cvt_pk_bf16(v0[0], v0[1]); w.y = cvt_pk_bf16(v0[2], v0[3]); w.z = cvt_pk_bf16(v1[0], v1[1]); w.w = cvt_pk_bf16(v1[2], v1[3]);
                    *(u32x4*)(base + (size_t)(row0 + ai * HALF + m * 16) * rstride) = w; } }
    }
};
__device__ __forceinline__ float silu_f(float x) { return x * __builtin_amdgcn_rcpf(1.0f + __expf(-x)); }
struct EpiSwiglu {
    static constexpr bool PERM = true, AFTER_DRAIN = false;
    bf16_t* O; int ldc;
    __device__ __forceinline__ void operator()(const f32x4 (&acc)[2][2][4][2], const Unit& u, int wr, int wc, int fr, int fq) const {
        const int row0 = u.pm * BM + wr * 64 + fr, col0 = u.pn * HALF + wc * 32 + 8 * fq;
#pragma unroll
        for (int ai = 0; ai < 2; ++ai)
#pragma unroll
            for (int m = 0; m < 4; ++m) { bf16_t* rowp = O + (size_t)(row0 + ai * HALF + m * 16) * ldc + col0;
                const f32x4 a0 = acc[ai][0][m][0], a1 = acc[ai][0][m][1], b0 = acc[ai][1][m][0], b1 = acc[ai][1][m][1];
                u32x4 w;
                w.x = cvt_pk_bf16(silu_f(a0[0]) * b0[0], silu_f(a0[1]) * b0[1]); w.y = cvt_pk_bf16(silu_f(a0[2]) * b0[2], silu_f(a0[3]) * b0[3]);
                w.z = cvt_pk_bf16(silu_f(a1[0]) * b1[0], silu_f(a1[1]) * b1[1]); w.w = cvt_pk_bf16(silu_f(a1[2]) * b1[2], silu_f(a1[3]) * b1[3]);
                *(u32x4*)rowp = w; }
    }
};
struct LatOrder {
    StaticOrder so;
    __device__ void init(int Mlat, int N, int G_, int c_) { so.init(Mlat, N, G_, c_); }
    __device__ bool next(int i, Unit& u) const { if (!so.next(i, u)) return false; u.pm += u.pm >> 5; return true; }
    __device__ __forceinline__ void a_ready(const Unit&) const {}
    __device__ __forceinline__ void done(const Unit&) const {}
};
struct CtxOrder {
    int c;
    __device__ bool next(int i, Unit& u) const { if (i > 0 || c >= 16) return false; u.pm = (c >> 2) * 33 + 32; u.pn = c & 3; return true; }
    __device__ __forceinline__ void a_ready(const Unit&) const {}
    __device__ __forceinline__ void done(const Unit&) const {}
};
struct CtxKvOrder {
    int c;
    __device__ bool next(int i, Unit& u) const { if (i > 0 || c >= 8) return false; u.pm = (c >> 1) * 33 + 32; u.pn = 4 + (c & 1); return true; }
    __device__ __forceinline__ void a_ready(const Unit&) const {}
    __device__ __forceinline__ void done(const Unit&) const {}
};
}
namespace attn {
using bf16 = __hip_bfloat16;
constexpr int   D = 128, NW = 8, QBLK = 32, KVBLK = 64;
constexpr float SCALE = 0.088388347648318440f;
constexpr float THR = 8.f;
constexpr int SDEPTH = 2;
constexpr int LDQ = 128, LDK = 128, LDO = 1024;
constexpr size_t SHM_V = KVBLK * D * 2, SHM_K = KVBLK * D * 2, SHM_ATTN = 2 * SHM_V + 2 * SHM_K + NW * 64 * 4;
using bf16x8 = __attribute__((ext_vector_type(8))) short;
using s16x4  = __attribute__((ext_vector_type(4))) short;
using f32x16 = __attribute__((ext_vector_type(16))) float;
using f32x8  = __attribute__((ext_vector_type(8))) float;
using u32x4  = __attribute__((ext_vector_type(4))) unsigned;
#define KSWZ(row, colB) ((row) * 256 + ((colB) ^ (((row) & 7) << 4)))
#define SBAR() __builtin_amdgcn_sched_barrier(0)
__device__ __forceinline__ int crow(int r, int hi) { return (r & 3) + 8 * (r >> 2) + 4 * hi; }
__device__ __forceinline__ unsigned cvtpk(float lo, float hi) {
  unsigned r; asm volatile("v_cvt_pk_bf16_f32 %0, %1, %2" : "=v"(r) : "v"(lo), "v"(hi)); return r;
}
template <typename TIn> struct Stage;
template <> struct Stage<bf16>  { using T = bf16x8;
  __device__ static __forceinline__ T ld8(const bf16* p) { return *reinterpret_cast<const bf16x8*>(p); }
  __device__ static __forceinline__ bf16x8 tobf(T x) { return x; } };
template <> struct Stage<float> { using T = f32x8;
  __device__ static __forceinline__ T ld8(const float* p) { return *reinterpret_cast<const f32x8*>(p); }
  __device__ static __forceinline__ bf16x8 tobf(T x) {
    u32x4 w = {cvtpk(x[0], x[1]), cvtpk(x[2], x[3]), cvtpk(x[4], x[5]), cvtpk(x[6], x[7])}; return *reinterpret_cast<bf16x8*>(&w); } };

__device__ __forceinline__ void partialSM(f32x16& p0, f32x16& p1, float& m_reg, float& mn, float& alpha) {
  constexpr float C = SCALE * 1.4426950408889634f;
  float pmax = p0[0]; for (int r = 1; r < 16; ++r) pmax = fmaxf(pmax, p0[r]); for (int r = 0; r < 16; ++r) pmax = fmaxf(pmax, p1[r]);
  { auto rr = __builtin_amdgcn_permlane32_swap(__float_as_uint(pmax), __float_as_uint(pmax), false, false);
    pmax = fmaxf(__uint_as_float(rr[0]), __uint_as_float(rr[1])); }
  if (__builtin_expect(__all(pmax - m_reg <= THR / SCALE), 1)) { mn = m_reg; alpha = 1.f; }
  else { mn = fmaxf(m_reg, pmax); alpha = __builtin_amdgcn_exp2f((m_reg - mn) * C); m_reg = mn; }
  float mnC = -mn * C;
  for (int r = 0; r < 16; ++r) p0[r] = fmaf(p0[r], C, mnC); for (int r = 0; r < 16; ++r) p1[r] = fmaf(p1[r], C, mnC);
  for (int r = 0; r < 16; ++r) p0[r] = __builtin_amdgcn_exp2f(p0[r]);
}
__device__ __forceinline__ void finishSM(f32x16& p0, f32x16& p1, float alpha, float& l_reg, bf16x8& pa0, bf16x8& pa1, bf16x8& pa2, bf16x8& pa3) {
  for (int r = 0; r < 16; ++r) p1[r] = __builtin_amdgcn_exp2f(p1[r]);
  float ps = 0; for (int r = 0; r < 16; ++r) ps += p0[r]; for (int r = 0; r < 16; ++r) ps += p1[r];
  { auto rr = __builtin_amdgcn_permlane32_swap(__float_as_uint(ps), __float_as_uint(ps), false, false);
    ps = __uint_as_float(rr[0]) + __uint_as_float(rr[1]); }
  l_reg = l_reg * alpha + ps;
#define PK4(P, BASE, OUT) do { unsigned a0 = cvtpk(P[BASE + 0], P[BASE + 1]), a1 = cvtpk(P[BASE + 2], P[BASE + 3]);   \
    unsigned b0 = cvtpk(P[BASE + 4], P[BASE + 5]), b1 = cvtpk(P[BASE + 6], P[BASE + 7]);                              \
    auto r0 = __builtin_amdgcn_permlane32_swap(a0, b0, false, false); auto r1 = __builtin_amdgcn_permlane32_swap(a1, b1, false, false); \
    u32x4 w = {r0[0], r1[0], r0[1], r1[1]}; OUT = *reinterpret_cast<bf16x8*>(&w); } while (0)
  PK4(p0, 0, pa0); PK4(p0, 8, pa1); PK4(p1, 0, pa2); PK4(p1, 8, pa3);
#undef PK4
}
__device__ __forceinline__ void qkt(f32x16& p0, f32x16& p1, const bf16* Ks, const bf16x8* qr, int r32, int hi) {
  p0 = f32x16{}; p1 = f32x16{};
  for (int d0 = 0; d0 < 8; ++d0) { int cb = (d0 * 16 + hi * 8) * 2;
    bf16x8 b0 = *reinterpret_cast<const bf16x8*>((const char*)Ks + KSWZ(r32, cb));
    bf16x8 b1 = *reinterpret_cast<const bf16x8*>((const char*)Ks + KSWZ(32 + r32, cb));
    p0 = __builtin_amdgcn_mfma_f32_32x32x16_bf16(b0, qr[d0], p0, 0, 0, 0);
    p1 = __builtin_amdgcn_mfma_f32_32x32x16_bf16(b1, qr[d0], p1, 0, 0, 0); }
}
__device__ __forceinline__ int v_st(int k, int c) { const int kk = (k & ~0xC) | ((k & 4) << 1) | ((k & 8) >> 1); return ((kk >> 3) * 4 + (c >> 5)) * 512 + ((kk & 7) * 32 + (c & 31)) * 2; }
__device__ __forceinline__ int v_rd_base(int lane) { return ((lane & 3) << 3) | (((lane >> 2) & 3) << 6) | (((lane >> 4) & 1) << 5) | (((lane >> 5) & 1) << 8); }
constexpr int v_rd_off(int d0, int ks, int half) { return d0 * 512 + ks * 4096 + half * 2048; }
template <int OFF> __device__ __forceinline__ s16x4 tr_read(int vb) {
  s16x4 r; asm volatile("ds_read_b64_tr_b16 %0, %1 offset:%2" : "=&v"(r) : "v"(vb), "i"(OFF) : "memory"); return r;
}
template <int D0> __device__ __forceinline__ void pv_one(f32x16& od, int vb, bf16x8 pa0, bf16x8 pa1, bf16x8 pa2, bf16x8 pa3) {
  const s16x4 l0 = tr_read<v_rd_off(D0, 0, 0)>(vb), h0 = tr_read<v_rd_off(D0, 0, 1)>(vb), l1 = tr_read<v_rd_off(D0, 1, 0)>(vb), h1 = tr_read<v_rd_off(D0, 1, 1)>(vb);
  const s16x4 l2 = tr_read<v_rd_off(D0, 2, 0)>(vb), h2 = tr_read<v_rd_off(D0, 2, 1)>(vb), l3 = tr_read<v_rd_off(D0, 3, 0)>(vb), h3 = tr_read<v_rd_off(D0, 3, 1)>(vb);
  asm volatile("s_waitcnt lgkmcnt(0)" ::: "memory"); SBAR();
#define PK(L, H) (bf16x8){L[0], L[1], L[2], L[3], H[0], H[1], H[2], H[3]}
  od = __builtin_amdgcn_mfma_f32_32x32x16_bf16(pa0, PK(l0, h0), od, 0, 0, 0);
  od = __builtin_amdgcn_mfma_f32_32x32x16_bf16(pa1, PK(l1, h1), od, 0, 0, 0);
  od = __builtin_amdgcn_mfma_f32_32x32x16_bf16(pa2, PK(l2, h2), od, 0, 0, 0);
  od = __builtin_amdgcn_mfma_f32_32x32x16_bf16(pa3, PK(l3, h3), od, 0, 0, 0);
#undef PK
}
__device__ __forceinline__ void pv_d0(f32x16* o, int vb, bf16x8 pa0, bf16x8 pa1, bf16x8 pa2, bf16x8 pa3) {
  pv_one<0>(o[0], vb, pa0, pa1, pa2, pa3); pv_one<1>(o[1], vb, pa0, pa1, pa2, pa3); pv_one<2>(o[2], vb, pa0, pa1, pa2, pa3); pv_one<3>(o[3], vb, pa0, pa1, pa2, pa3);
}

template <typename TQ>
__device__ __forceinline__ void attn_dense_body(const TQ* __restrict__ Qb, const bf16* __restrict__ Kh, const bf16* __restrict__ Vh,
                                                unsigned short* __restrict__ Ob, int seq, char* lds) {
  using St = Stage<bf16>; using SQ = Stage<TQ>;
  const int tid = threadIdx.x, wid = tid >> 6, lane = tid & 63, r32 = lane & 31, hi = lane >> 5;
  bf16* V_lds = (bf16*)lds; bf16* K_lds = (bf16*)(lds + 2 * SHM_V);
  float* ws = (float*)(lds + 2 * SHM_V + 2 * SHM_K) + wid * 64; float* li_l = ws; float* al_l = ws + 32;
  float m_reg = -1e30f, l_reg = 0; f32x16 o[4] = {}; bf16x8 qr[8];
  const TQ* Qw = Qb + (long)(wid * QBLK + r32) * LDQ + hi * 8;
#pragma unroll
  for (int d0 = 0; d0 < 8; ++d0) qr[d0] = SQ::tobf(SQ::ld8(Qw + d0 * 16));
  const int sr = tid >> 4, sc = (tid & 15) * 8, vst0 = v_st(sr, sc), vst1 = v_st(32 + sr, sc);
  const int vb0 = (int)(uintptr_t)V_lds + v_rd_base(lane);
  struct { typename St::T vs0, vs1, ks0, ks1; } sr_[SDEPTH];
#define SLOAD(i, k0) do { sr_[i].vs0 = St::ld8(&Vh[(long)((k0) + sr) * LDK + sc]); sr_[i].vs1 = St::ld8(&Vh[(long)((k0) + 32 + sr) * LDK + sc]); \
    sr_[i].ks0 = St::ld8(&Kh[(long)((k0) + sr) * LDK + sc]); sr_[i].ks1 = St::ld8(&Kh[(long)((k0) + 32 + sr) * LDK + sc]); } while (0)
#define SWRITE(b, i) do { *(bf16x8*)((char*)V_lds + (b) * SHM_V + vst0) = St::tobf(sr_[i].vs0);          \
    *(bf16x8*)((char*)V_lds + (b) * SHM_V + vst1) = St::tobf(sr_[i].vs1); int kc = sc * 2;               \
    *(bf16x8*)((char*)K_lds + (b) * SHM_K + KSWZ(sr, kc)) = St::tobf(sr_[i].ks0);                       \
    *(bf16x8*)((char*)K_lds + (b) * SHM_K + KSWZ(32 + sr, kc)) = St::tobf(sr_[i].ks1); } while (0)
#define SWAIT() do { if constexpr (SDEPTH == 2) asm volatile("s_waitcnt vmcnt(4)" ::: "memory"); else asm volatile("s_waitcnt vmcnt(0)" ::: "memory"); } while (0)
#define RESC(a) do { if (__any((a) < 1.f)) { if (hi == 0) al_l[r32] = (a); asm volatile("s_waitcnt lgkmcnt(0)" ::: "memory"); \
    for (int d = 0; d < 4; ++d) for (int r = 0; r < 16; ++r) o[d][r] *= al_l[crow(r, hi)]; } } while (0)
  f32x16 pA0, pA1, pB0, pB1; float mnA, mnB, alA, alB; bf16x8 pa0, pa1, pa2, pa3; const int NT = seq / KVBLK;
  constexpr int SE = 0, SO = SDEPTH - 1;
  SLOAD(SE, 0); asm volatile("s_waitcnt vmcnt(0)" ::: "memory"); SWRITE(0, SE); __syncthreads();
  qkt(pA0, pA1, K_lds, qr, r32, hi); partialSM(pA0, pA1, m_reg, mnA, alA);
  SLOAD(SO, KVBLK); if constexpr (SDEPTH == 2) { if (2 < NT) SLOAD(SE, 2 * KVBLK); }
  SWAIT(); SWRITE(1, SO); __syncthreads();
  for (int j = 1; j + 1 < NT; j += 2) {
    SBAR(); qkt(pB0, pB1, (bf16*)((char*)K_lds + SHM_K), qr, r32, hi);
    finishSM(pA0, pA1, alA, l_reg, pa0, pa1, pa2, pa3); SBAR();
    SLOAD(SO, (j + SDEPTH) * KVBLK); SBAR();
    pv_d0(o, vb0, pa0, pa1, pa2, pa3); partialSM(pB0, pB1, m_reg, mnB, alB);
    __syncthreads(); SWAIT(); SWRITE(0, SE);
    RESC(alB); __syncthreads();
    SBAR(); qkt(pA0, pA1, K_lds, qr, r32, hi);
    finishSM(pB0, pB1, alB, l_reg, pa0, pa1, pa2, pa3); SBAR();
    { const int jn = (j + 1 + SDEPTH < NT) ? (j + 1 + SDEPTH) : (NT - 1); SLOAD(SE, jn * KVBLK); } SBAR();
    pv_d0(o, vb0 + (int)SHM_V, pa0, pa1, pa2, pa3); partialSM(pA0, pA1, m_reg, mnA, alA);
    __syncthreads(); SWAIT(); SWRITE(1, SO);
    RESC(alA); __syncthreads();
  }
  SBAR(); qkt(pB0, pB1, (bf16*)((char*)K_lds + SHM_K), qr, r32, hi);
  finishSM(pA0, pA1, alA, l_reg, pa0, pa1, pa2, pa3); SBAR();
  pv_d0(o, vb0, pa0, pa1, pa2, pa3); partialSM(pB0, pB1, m_reg, mnB, alB);
  __syncthreads(); RESC(alB);
  finishSM(pB0, pB1, alB, l_reg, pa0, pa1, pa2, pa3); SBAR();
  pv_d0(o, vb0 + (int)SHM_V, pa0, pa1, pa2, pa3);
  if (hi == 0) li_l[r32] = l_reg; asm volatile("s_waitcnt lgkmcnt(0)" ::: "memory");
  float rli[16];
#pragma unroll
  for (int r = 0; r < 16; ++r) rli[r] = __builtin_amdgcn_rcpf(li_l[crow(r, hi)]);
  unsigned short* Ow = Ob + (long)(wid * QBLK) * LDO;
#pragma unroll
  for (int r = 0; r < 16; ++r) { int orow = crow(r, hi);
    for (int d0 = 0; d0 < 4; ++d0) Ow[(long)orow * LDO + d0 * 32 + r32] = (unsigned short)(cvtpk(o[d0][r] * rli[r], 0.f) & 0xffffu); }
#undef SLOAD
#undef SWRITE
#undef SWAIT
#undef RESC
}
}
namespace mk {
typedef unsigned short bf16_t;
typedef short bf16x8 __attribute__((ext_vector_type(8)));
typedef float f32x4 __attribute__((ext_vector_type(4)));
typedef unsigned u32x4 __attribute__((ext_vector_type(4)));
typedef unsigned u32x2 __attribute__((ext_vector_type(2)));
#define LAS __attribute__((address_space(3)))
constexpr int NWAVES = 8, NTHR = 512;
constexpr int DM = 1024, NB = 4, SEQL = 8192, CTXL = 256, ROWS_B = SEQL + CTXL  , MROWS = NB * ROWS_B  , MLAT = NB * SEQL;
constexpr int ABIN = 3072, FFH = 2816, FFIN = 2 * FFH, ATTIN = 1536;
constexpr int NCHUNK = ROWS_B / 64  , NCHAIN = 32, NTASK_A = NCHAIN * NCHUNK  , NTASK_POOL = MROWS / 64  , NTASK_C = 16 * NCHUNK  ;
constexpr float EPS = 1e-6f;
constexpr size_t MiB = 1u << 20;
constexpr size_t WS_CTL = 0, CTL_ZERO_BYTES = 1 * MiB, WS_MODS = 256 * 1024;
constexpr size_t WS_W_ABIN = 2 * MiB, WS_W_ABOUT = 8 * MiB, WS_W_ATTIN = 10 * MiB, WS_W_ATTOUT = 13 * MiB, WS_W_FFIN = 15 * MiB, WS_W_FFOUT = 37 * MiB;
constexpr size_t WS_POOLWT = 48 * MiB, WS_DEC = 49 * MiB, WS_CTXS = 52 * MiB;
constexpr size_t WS_XN = 60 * MiB, WS_Y = 126 * MiB, WS_SB = 60 * MiB, WS_Z = 192 * MiB, WS_MIX = 390 * MiB, WS_END = 456 * MiB;
constexpr size_t WS_QC = 292 * MiB, WS_KC = 356 * MiB, WS_VC = 373 * MiB;
constexpr int LDS_BYTES = 147456;
constexpr int N_PHASES = 19;

__device__ __forceinline__ float bf2f(bf16_t h) { return __uint_as_float((unsigned)h << 16); }
typedef __bf16 bf16x2_t __attribute__((ext_vector_type(2)));
typedef float f32x2_t __attribute__((ext_vector_type(2)));
__device__ __forceinline__ unsigned cvtpk(float lo, float hi) { const f32x2_t f = {lo, hi}; const bf16x2_t v = __builtin_convertvector(f, bf16x2_t); return __builtin_bit_cast(unsigned, v); }
__device__ __forceinline__ unsigned f2bf(float f) { return cvtpk(f, 0.f) & 0xffffu; }
__device__ __forceinline__ unsigned pk2(float lo, float hi) { return cvtpk(lo, hi); }
__device__ __forceinline__ float sigmoid_f(float x) { return 1.0f / (1.0f + __expf(-x)); }
template <int CTRL, int ROWMASK> __device__ __forceinline__ float dpp_get(float v) { return __builtin_bit_cast(float, __builtin_amdgcn_update_dpp(0, __builtin_bit_cast(int, v), CTRL, ROWMASK, 0xf, false)); }
__device__ __forceinline__ float row16_sum(float v) { v += dpp_get<0xB1, 0xf>(v); v += dpp_get<0x4E, 0xf>(v); v += dpp_get<0x141, 0xf>(v); v += dpp_get<0x140, 0xf>(v); return v; }
__device__ __forceinline__ float wave_sum(float v) {
    v = row16_sum(v); v += dpp_get<0x142, 0xa>(v); v += dpp_get<0x143, 0xc>(v);
    return __builtin_bit_cast(float, __builtin_amdgcn_readlane(__builtin_bit_cast(int, v), 63));
}

__device__ __forceinline__ void transpose_item(const float* W, int K, int N, bf16_t* WT, int k0, int n0, int drow0, float* scr, int lane) {
#pragma unroll
    for (int i = 0; i < 8; ++i) { const int kk = 8 * i + (lane >> 3), n4 = (lane & 7) * 4; const f32x4 v = *(const f32x4*)(W + (size_t)(k0 + kk) * N + n0 + n4);
        scr[kk * 33 + n4] = v.x; scr[kk * 33 + n4 + 1] = v.y; scr[kk * 33 + n4 + 2] = v.z; scr[kk * 33 + n4 + 3] = v.w; }
    asm volatile("s_waitcnt lgkmcnt(0)" ::: "memory");
    const int c = lane & 7;
#pragma unroll
    for (int j = 0; j < 4; ++j) { const int n = (lane >> 3) + 8 * j; const float* s = scr + (8 * c) * 33 + n;
        u32x4 o; o.x = pk2(s[0 * 33], s[1 * 33]); o.y = pk2(s[2 * 33], s[3 * 33]); o.z = pk2(s[4 * 33], s[5 * 33]); o.w = pk2(s[6 * 33], s[7 * 33]);
        *(u32x4*)(WT + (size_t)(drow0 + n) * K + k0 + 8 * c) = o; }
    asm volatile("s_waitcnt lgkmcnt(0)" ::: "memory");
}
__device__ __forceinline__ void transpose_plain(const float* W, int K, int N, bf16_t* WT, int item, float* scr, int lane) {
    const int nblk = N / 32, kb = item / nblk, nb = item % nblk; transpose_item(W, K, N, WT, 64 * kb, 32 * nb, 32 * nb, scr, lane);
}
__device__ __forceinline__ void transpose_abin(const float* W, bf16_t* WT, int item, float* scr, int lane) {
    const int nblk = ABIN / 32, kb = item / nblk, nb = item % nblk; const int n0 = 32 * nb;
    int drow0; if (n0 < 512) drow0 = n0; else { const int grp = (n0 - 512) / 512, hh = ((n0 - 512) % 512) / 128, j0 = n0 % 128; drow0 = 512 + hh * 640 + grp * 128 + j0; }
    transpose_item(W, DM, ABIN, WT, 64 * kb, n0, drow0, scr, lane);
}
__device__ __forceinline__ void transpose_ffin(const float* W, bf16_t* WT, int item, float* scr, int lane) {
    const int nblk = FFIN / 32, kb = item / nblk, nb = item % nblk; const int n0 = 32 * nb;
    int drow0; if (n0 < FFH) drow0 = 256 * (n0 / 128) + (n0 % 128); else { const int m0 = n0 - FFH; drow0 = 256 * (m0 / 128) + 128 + (m0 % 128); }
    transpose_item(W, DM, FFIN, WT, 64 * kb, n0, drow0, scr, lane);
}
__device__ __forceinline__ void ada_item(int item, const float* c, const float* c_ctx, const float* ada_w, const float* ada_b, float* mods, int lane) {
    const int kc = item & 15, nb = (item >> 4) % 96, l = item / (16 * 96);
    const int k0 = kc * 64, n = nb * 64 + lane;
    float sv[5];
#pragma unroll
    for (int r = 0; r < 5; ++r) { const float v = (r < 4) ? c[r * DM + k0 + lane] : c_ctx[k0 + lane]; sv[r] = v * sigmoid_f(v); }
    float acc[5] = {0.f, 0.f, 0.f, 0.f, 0.f};
    const float* wp = ada_w + ((size_t)l * DM + k0) * 6144 + n;
#pragma unroll 16
    for (int kk = 0; kk < 64; ++kk) { const float w = wp[(size_t)kk * 6144];
#pragma unroll
        for (int r = 0; r < 5; ++r) acc[r] += __shfl(sv[r], kk) * w; }
    const float bias = (kc == 0) ? ada_b[l * 6144 + n] : 0.f;
#pragma unroll
    for (int r = 0; r < 5; ++r) atomicAdd(mods + ((size_t)l * 5 + r) * 6144 + n, acc[r] + bias);
}

struct RowRegs { f32x4 v[4]; u32x2 yw[4]; };
template <bool HAS_Y>
__device__ __forceinline__ void row_load(RowRegs& R, int row, bool on, int lane, const float* xin_lat, const float* xin_ctx, const bf16_t* Y) {
    if (!on) return;
    const int b = row / ROWS_B, p = row - b * ROWS_B; const bool isctx = p >= SEQL;
    const size_t xoff = isctx ? (size_t)(b * CTXL + p - SEQL) * DM : (size_t)(b * SEQL + p) * DM;
    const float* xin = (isctx ? xin_ctx : xin_lat) + xoff;
#pragma unroll
    for (int j = 0; j < 4; ++j) R.v[j] = __builtin_nontemporal_load((const f32x4*)(xin + 4 * lane + 256 * j));
    if (HAS_Y) { const bf16_t* yr = Y + (size_t)row * DM;
#pragma unroll
        for (int j = 0; j < 4; ++j) R.yw[j] = __builtin_nontemporal_load((const u32x2*)(yr + 4 * lane + 256 * j)); }
}
template <bool HAS_Y, bool WRITE_X, bool HAS_XN>
__device__ __forceinline__ void row_finish(RowRegs& R, int row, bool on, int lane, float* xout_lat, float* xout_ctx, const float* PRM, bf16_t* XN) {
    if (!on) return;
    const int b = row / ROWS_B, p = row - b * ROWS_B; const bool isctx = p >= SEQL; const int r = isctx ? 4 : b;
    const size_t xoff = isctx ? (size_t)(b * CTXL + p - SEQL) * DM : (size_t)(b * SEQL + p) * DM;
    const float* PG = PRM + r * DM; const float* PA = PRM + 5 * DM + r * DM; const float* PS = PRM + 10 * DM + r * DM;
    f32x4 (&v)[4] = R.v;
    if (HAS_Y) {
        f32x4 y[4]; float ss = 0.f;
#pragma unroll
        for (int j = 0; j < 4; ++j) { const u32x2 w = R.yw[j];
            y[j] = (f32x4){__uint_as_float(w.x << 16), __uint_as_float(w.x & 0xffff0000u), __uint_as_float(w.y << 16), __uint_as_float(w.y & 0xffff0000u)};
            ss += (y[j].x * y[j].x + y[j].y * y[j].y) + (y[j].z * y[j].z + y[j].w * y[j].w); }
        const float rstd = rsqrtf(wave_sum(ss) * (1.f / DM) + EPS);
#pragma unroll
        for (int j = 0; j < 4; ++j) { const f32x4 g = *(const f32x4*)(PG + 4 * lane + 256 * j); v[j] = v[j] + g * (y[j] * rstd); }
    }
    if (WRITE_X) { float* xo = (isctx ? xout_ctx : xout_lat) + xoff;
#pragma unroll
        for (int j = 0; j < 4; ++j) __builtin_nontemporal_store(v[j], (f32x4*)(xo + 4 * lane + 256 * j)); }
    if (HAS_XN) {
        float ss = 0.f;
#pragma unroll
        for (int j = 0; j < 4; ++j) ss += (v[j].x * v[j].x + v[j].y * v[j].y) + (v[j].z * v[j].z + v[j].w * v[j].w);
        const float rstd = rsqrtf(wave_sum(ss) * (1.f / DM) + EPS);
        bf16_t* xo = XN + (size_t)row * DM;
#pragma unroll
        for (int j = 0; j < 4; ++j) { const f32x4 pa = *(const f32x4*)(PA + 4 * lane + 256 * j), sh = *(const f32x4*)(PS + 4 * lane + 256 * j);
            const f32x4 o = v[j] * rstd * pa + sh;
            u32x2 w; w.x = pk2(o.x, o.y); w.y = pk2(o.z, o.w); *(u32x2*)(xo + 4 * lane + 256 * j) = w; }
    }
}
template <bool HAS_Y, bool WRITE_X, bool HAS_XN>
__device__ __forceinline__ void row_phase(int gw, int NGW, int lane, int tid, float* PRM  , int rmode  ,
        const float* xin_lat, const float* xin_ctx, float* xout_lat, float* xout_ctx,
        const bf16_t* Y, const float* mods_y, int gate_idx, const float* ngy,
        const float* ng2, const float* mods_n, int sh_idx, int sc_idx, bf16_t* XN) {
    for (int idx = tid; idx < 5 * DM; idx += NTHR) { const int r = idx >> 10, c = idx & (DM - 1);
        if (HAS_Y) PRM[idx] = mods_y[((size_t)r * 6 + gate_idx) * DM + c] * ngy[c];
        if (HAS_XN) { PRM[5 * DM + idx] = ng2[c] * (1.0f + mods_n[((size_t)r * 6 + sc_idx) * DM + c]); PRM[10 * DM + idx] = mods_n[((size_t)r * 6 + sh_idx) * DM + c]; } }
    __syncthreads();
#define ROW_ON(rr) (((rr) < MROWS) && (rmode == 0 || ((((rr) % ROWS_B) >= SEQL) == (rmode == 2))))
    RowRegs A, B, C, D;
    int row = gw;
    if (row < MROWS) {
        row_load<HAS_Y>(A, row, ROW_ON(row), lane, xin_lat, xin_ctx, Y); row_load<HAS_Y>(B, row + NGW, ROW_ON(row + NGW), lane, xin_lat, xin_ctx, Y);
        for (;;) {
            int nrow = row + 2 * NGW; bool more = nrow < MROWS;
            if (more) { row_load<HAS_Y>(C, nrow, ROW_ON(nrow), lane, xin_lat, xin_ctx, Y); row_load<HAS_Y>(D, nrow + NGW, ROW_ON(nrow + NGW), lane, xin_lat, xin_ctx, Y); }
            row_finish<HAS_Y, WRITE_X, HAS_XN>(A, row, ROW_ON(row), lane, xout_lat, xout_ctx, PRM, XN);
            row_finish<HAS_Y, WRITE_X, HAS_XN>(B, row + NGW, ROW_ON(row + NGW), lane, xout_lat, xout_ctx, PRM, XN);
            if (!more) break;
            row = nrow; nrow = row + 2 * NGW; more = nrow < MROWS;
            if (more) { row_load<HAS_Y>(A, nrow, ROW_ON(nrow), lane, xin_lat, xin_ctx, Y); row_load<HAS_Y>(B, nrow + NGW, ROW_ON(nrow + NGW), lane, xin_lat, xin_ctx, Y); }
            row_finish<HAS_Y, WRITE_X, HAS_XN>(C, row, ROW_ON(row), lane, xout_lat, xout_ctx, PRM, XN);
            row_finish<HAS_Y, WRITE_X, HAS_XN>(D, row + NGW, ROW_ON(row + NGW), lane, xout_lat, xout_ctx, PRM, XN);
            if (!more) break;
            row = nrow;
        }
    }
#undef ROW_ON
    __syncthreads();
}

__device__ __forceinline__ float lb_of(const float* hg_lower, int dir, int ch) { const float a0 = hg_lower[dir * 512 + ch], a1 = hg_lower[1024 + dir * 512 + ch]; return 1.0f / (1.0f + __expf(a1 - a0)); }


__device__ __forceinline__ void tile_load(u32x4 (&r)[2], const bf16_t* base, int ld, int tid) {
#pragma unroll
    for (int k = 0; k < 2; ++k) { const int idx = tid + 512 * k; r[k] = *(const u32x4*)(base + (size_t)(idx >> 4) * ld + (idx & 15) * 8); }
}
__device__ __forceinline__ void tile_to_lds(const u32x4 (&r)[2], bf16_t* dst  , int tid) {
#pragma unroll
    for (int k = 0; k < 2; ++k) { const int idx = tid + 512 * k; *(u32x4*)(dst + idx * 8) = r[k]; }
}
struct Gate { float f[16], kv[16]; float run; };
__device__ __forceinline__ void gate_math(Gate& G_, const bf16_t* ZR, float lbv, int d, int seg) {
    float run = 1.f;
#pragma unroll
    for (int ii = 0; ii < 16; ++ii) { const float z = bf2f(ZR[(seg * 16 + ii) * 128 + d]); const float sg = __builtin_amdgcn_rcpf(1.0f + __expf(-z)); const float f = lbv + (1.f - lbv) * sg;
        G_.kv[ii] = (1.f - lbv) * (1.f - sg); G_.f[ii] = f; run *= f; }
    G_.run = run;
}
__device__ __forceinline__ void hgrn_a_load(int task, const bf16_t* Z, u32x4 (&rzf)[2], u32x4 (&rzb)[2], u32x4 (&rv)[2], int tid) {
    const int bh = task / NCHUNK, nc = task - bh * NCHUNK, b = bh >> 2, h = bh & 3;
    const int row0 = b * ROWS_B + (nc < 128 ? nc * 64 : SEQL + (nc - 128) * 64);
    const bf16_t* zb_ = Z + ((size_t)h * MROWS + row0) * 640;
    tile_load(rzf, zb_ + 128, 640, tid); tile_load(rzb, zb_ + 256, 640, tid); tile_load(rv, zb_ + 384, 640, tid);
}
__device__ __forceinline__ void hgrn_a_task(int task, int next_task, u32x4 (&rzf)[2], u32x4 (&rzb)[2], u32x4 (&rv)[2], const bf16_t* Z, const float* hg_lower, bf16_t* SB, float* DEC, char* lds, int tid) {
    const int bh = task / NCHUNK, nc = task - bh * NCHUNK, b = bh >> 2, h = bh & 3;
    const int row0 = b * ROWS_B + (nc < 128 ? nc * 64 : SEQL + (nc - 128) * 64);
    bf16_t* RZF = (bf16_t*)lds;
    bf16_t* RZB = (bf16_t*)(lds + 16384);
    bf16_t* RV = (bf16_t*)(lds + 32768);
    bf16_t* KT0 = (bf16_t*)(lds + 49152);
    bf16_t* VT = (bf16_t*)(lds + 49152 + 2 * 18432);
    float* TOT = (float*)(lds + 49152 + 3 * 18432);
    const int d = tid & 127, seg = tid >> 7, ch = h * 128 + d;
    const float lb0 = lb_of(hg_lower, 0, ch), lb1 = lb_of(hg_lower, 1, ch);
    tile_to_lds(rzf, RZF, tid); tile_to_lds(rzb, RZB, tid); tile_to_lds(rv, RV, tid);
    __syncthreads();
    if (next_task >= 0) hgrn_a_load(next_task, Z, rzf, rzb, rv, tid);
    {
        unsigned w[8];
#pragma unroll
        for (int i2 = 0; i2 < 8; ++i2) w[i2] = (unsigned)RV[(seg * 16 + 2 * i2) * 128 + d] | ((unsigned)RV[(seg * 16 + 2 * i2 + 1) * 128 + d] << 16);
        *(u32x4*)(VT + d * 72 + seg * 16) = (u32x4){w[0], w[1], w[2], w[3]}; *(u32x4*)(VT + d * 72 + seg * 16 + 8) = (u32x4){w[4], w[5], w[6], w[7]};
    }
    Gate g0, g1;
    gate_math(g0, RZF, lb0, d, seg); gate_math(g1, RZB, lb1, d, seg);
    TOT[seg * 128 + d] = g0.run; TOT[512 + seg * 128 + d] = g1.run;
    __syncthreads();
#pragma unroll
    for (int dir = 0; dir < 2; ++dir) {
        const Gate& gg = dir ? g1 : g0;
        float offp = 1.f, offs = 1.f;
#pragma unroll
        for (int s = 0; s < 4; ++s) { const float tv = TOT[dir * 512 + s * 128 + d]; if (s < seg) offp *= tv; if (s > seg) offs *= tv; }
        const float total = offp * gg.run * offs;
        float kk[16];
        if (dir == 0) { float acc = offs;
#pragma unroll
            for (int ii = 15; ii >= 0; --ii) { kk[ii] = gg.kv[ii] * acc; acc *= gg.f[ii]; } }
        else { float acc = offp;
#pragma unroll
            for (int ii = 0; ii < 16; ++ii) { kk[ii] = gg.kv[ii] * acc; acc *= gg.f[ii]; } }
        unsigned w[8];
#pragma unroll
        for (int i2 = 0; i2 < 8; ++i2) w[i2] = cvtpk(kk[2 * i2], kk[2 * i2 + 1]);
        bf16_t* KT = KT0 + dir * (128 * 72);
        *(u32x4*)(KT + d * 72 + seg * 16) = (u32x4){w[0], w[1], w[2], w[3]}; *(u32x4*)(KT + d * 72 + seg * 16 + 8) = (u32x4){w[4], w[5], w[6], w[7]};
        if (seg == 0) { const int cc = (nc < 128) ? (dir ? 4 + (127 - nc) : 4 + nc) : (dir ? 3 - (nc - 128) : (nc - 128)); const int t = ((dir * 4 + b) * 4 + h) * NCHUNK + cc; DEC[(size_t)t * 128 + d] = total; }
    }
    __syncthreads();
    const int wave = tid >> 6, lane = tid & 63, fr = lane & 15, fq = lane >> 4;
#pragma unroll
    for (int dir = 0; dir < 2; ++dir) {
        const bf16_t* KT = KT0 + dir * (128 * 72);
        const int cc = (nc < 128) ? (dir ? 4 + (127 - nc) : 4 + nc) : (dir ? 3 - (nc - 128) : (nc - 128)); const int t = ((dir * 4 + b) * 4 + h) * NCHUNK + cc;
        bf16x8 a[2];
#pragma unroll
        for (int ks = 0; ks < 2; ++ks) a[ks] = *(const bf16x8*)(KT + (wave * 16 + fr) * 72 + ks * 32 + fq * 8);
#pragma unroll
        for (int et = 0; et < 8; ++et) { f32x4 acc = {0.f, 0.f, 0.f, 0.f};
#pragma unroll
            for (int ks = 0; ks < 2; ++ks) { const bf16x8 bv = *(const bf16x8*)(VT + (et * 16 + fr) * 72 + ks * 32 + fq * 8); acc = __builtin_amdgcn_mfma_f32_16x16x32_bf16(a[ks], bv, acc, 0, 0, 0); }
            u32x2 w; w.x = cvtpk(acc[0], acc[1]); w.y = cvtpk(acc[2], acc[3]);
            *(u32x2*)((bf16_t*)(lds + (dir ? 108544 : 0)) + (et * 16 + fr) * 136 + wave * 16 + fq * 4) = w; }
    }
    __syncthreads();
#pragma unroll
    for (int dir = 0; dir < 2; ++dir) {
        const int cc = (nc < 128) ? (dir ? 4 + (127 - nc) : 4 + nc) : (dir ? 3 - (nc - 128) : (nc - 128)); const int t = ((dir * 4 + b) * 4 + h) * NCHUNK + cc;
        const bf16_t* OSB = (const bf16_t*)(lds + (dir ? 108544 : 0));
#pragma unroll
        for (int k = 0; k < 4; ++k) { const int idx = tid + 512 * k; *(u32x4*)(SB + (size_t)t * 16384 + idx * 8) = *(const u32x4*)(OSB + (idx >> 4) * 136 + (idx & 15) * 8); }
    }
    __syncthreads();
}

__device__ __forceinline__ void pool_task(int nt, const bf16_t* Z, const bf16_t* PWT, const float* pool_scale, bf16_t* MIX, char* lds, int tid) {
    const int row0 = nt * 64, b = row0 / ROWS_B, p0 = row0 - b * ROWS_B; const bool isctx = p0 >= SEQL;
    const int seg_lo = b * ROWS_B + (isctx ? SEQL : 0), Ln = isctx ? CTXL : SEQL, t0 = row0 - seg_lo;
    bf16_t* UR = (bf16_t*)lds;
    bf16_t* YH = (bf16_t*)(lds + 80 * 512 * 2);
    {
        u32x4 r[10];
#pragma unroll
        for (int k = 0; k < 10; ++k) { const int idx = tid + 512 * k, jj = idx >> 6, c8 = idx & 63; const int tp = t0 - 8 + jj; const int tpc = min(max(tp, 0), Ln - 1);
            r[k] = *(const u32x4*)(Z + (size_t)(seg_lo + tpc) * 512 + c8 * 8); if (tp != tpc) r[k] = (u32x4){0u, 0u, 0u, 0u}; }
#pragma unroll
        for (int k = 0; k < 10; ++k) { const int idx = tid + 512 * k; *(u32x4*)(UR + idx * 8) = r[k]; }
    }
    __syncthreads();
    const int c = tid & 127, rs = tid >> 7;
    const int wave = tid >> 6, lane = tid & 63, fr = lane & 15, fq = lane >> 4;
    for (int g = 0; g < 4; ++g) {
        const int half = 1 << g; const bf16_t* U = UR + g * 128 + c;
        {
            int t = t0 + rs * 16; int lo = max(t - half, 0), hi = min(t + half, Ln); float s = 0.f;
            for (int j = lo; j < hi; ++j) s += bf2f(U[(j - t0 + 8) * 512]);
            for (int ii = 0; ii < 16; ++ii) { const int n = rs * 16 + ii; t = t0 + n;
                const float y = s * __builtin_amdgcn_rcpf((float)(hi - lo)) - bf2f(U[(n + 8) * 512]); YH[n * 136 + c] = (bf16_t)f2bf(y);
                const int nlo = max(t + 1 - half, 0), nhi = min(t + 1 + half, Ln);
                if (nhi > hi) s += bf2f(U[(nhi - 1 - t0 + 8) * 512]);
                if (nlo > lo) s -= bf2f(U[(lo - t0 + 8) * 512]);
                lo = nlo; hi = nhi; }
        }
        bf16x8 a[4];
#pragma unroll
        for (int ks = 0; ks < 4; ++ks) a[ks] = *(const bf16x8*)(PWT + (size_t)g * 16384 + (wave * 16 + fr) * 128 + ks * 32 + fq * 8);
        const f32x4 ps = *(const f32x4*)(pool_scale + g * 128 + wave * 16 + fq * 4);
        __syncthreads();
#pragma unroll
        for (int ntile = 0; ntile < 4; ++ntile) { f32x4 acc = {0.f, 0.f, 0.f, 0.f};
#pragma unroll
            for (int ks = 0; ks < 4; ++ks) { const bf16x8 bv = *(const bf16x8*)(YH + (ntile * 16 + fr) * 136 + ks * 32 + fq * 8); acc = __builtin_amdgcn_mfma_f32_16x16x32_bf16(a[ks], bv, acc, 0, 0, 0); }
            acc = acc * ps; u32x2 w; w.x = cvtpk(acc[0], acc[1]); w.y = cvtpk(acc[2], acc[3]);
            *(u32x2*)(MIX + (size_t)(row0 + ntile * 16 + fr) * DM + g * 128 + wave * 16 + fq * 4) = w; }
        __syncthreads();
    }
}

__device__ __forceinline__ void hgrn_b(int vcu, int G, int tid, bf16_t* SB, const float* DEC) {
    for (int idx = vcu * NTHR + tid; idx < NCHAIN * 4096; idx += G * NTHR) {
        const int chain = idx >> 12, rem = idx & 4095, dq = rem & 31;
        f32x4 S = {0.f, 0.f, 0.f, 0.f};
        bf16_t* p = SB + (size_t)chain * NCHUNK * 16384 + rem * 4; const float* dp = DEC + (size_t)chain * NCHUNK * 128 + dq * 4;
#pragma unroll 22
        for (int cc = 0; cc < NCHUNK; ++cc) {
            const u32x2 w = *(const u32x2*)(p + (size_t)cc * 16384); const f32x4 dec = *(const f32x4*)(dp + cc * 128);
            u32x2 o; o.x = pk2(S.x, S.y); o.y = pk2(S.z, S.w); *(u32x2*)(p + (size_t)cc * 16384) = o;
            const f32x4 ds = {__uint_as_float(w.x << 16), __uint_as_float(w.x & 0xffff0000u), __uint_as_float(w.y << 16), __uint_as_float(w.y & 0xffff0000u)};
            S = dec * S + ds;
        }
    }
}

__device__ __forceinline__ void hgrn_c_load(int task, const bf16_t* Z, u32x4 (&rq)[2], u32x4 (&rzf)[2], u32x4 (&rv)[2], int tid) {
    const int bh = task / NCHUNK, nc = task - bh * NCHUNK, b = bh >> 2, h = bh & 3;
    const int row0 = b * ROWS_B + (nc < 128 ? nc * 64 : SEQL + (nc - 128) * 64);
    const bf16_t* zb_ = Z + ((size_t)h * MROWS + row0) * 640;
    tile_load(rq, zb_, 640, tid); tile_load(rzf, zb_ + 128, 640, tid); tile_load(rv, zb_ + 384, 640, tid);
}
__device__ __forceinline__ void hgrn_c_load_s0(int task, const bf16_t* SB, u32x4 (&rs0)[4], int tid) {
    const int bh = task / NCHUNK, nc = task - bh * NCHUNK, b = bh >> 2, h = bh & 3;
    const int cc0 = (nc < 128) ? 4 + nc : (nc - 128);
    const bf16_t* S0 = SB + (size_t)(((0 * 4 + b) * 4 + h) * NCHUNK + cc0) * 16384;
#pragma unroll
    for (int k = 0; k < 4; ++k) rs0[k] = *(const u32x4*)(S0 + (tid + 512 * k) * 8);
}
__device__ __forceinline__ void hgrn_c_task(int task, int next_task, u32x4 (&rq)[2], u32x4 (&rzf)[2], u32x4 (&rv)[2], u32x4 (&rs0)[4], const bf16_t* Z, const float* hg_lower, const float* onorm_g, const bf16_t* SB, bf16_t* MIX, char* lds, int tid) {
    const int bh = task / NCHUNK, nc = task - bh * NCHUNK, b = bh >> 2, h = bh & 3;
    const int row0 = b * ROWS_B + (nc < 128 ? nc * 64 : SEQL + (nc - 128) * 64);
    bf16_t* QH = (bf16_t*)lds;
    bf16_t* KH = (bf16_t*)(lds + 17408);
    bf16_t* VT = (bf16_t*)(lds + 34816);
    bf16_t* P = (bf16_t*)(lds + 53248);
    float* TOT = (float*)(lds + 62464);
    bf16_t* RQ = (bf16_t*)(lds + 64512);
    bf16_t* RZ = (bf16_t*)(lds + 80896);
    bf16_t* SL = (bf16_t*)(lds + 97280);
    bf16_t* RV = SL;
    float* OS = (float*)lds;
    const int d = tid & 127, seg = tid >> 7, ch = h * 128 + d;
    const int wave = tid >> 6, lane = tid & 63, fr = lane & 15, fq = lane >> 4;
    const int it = wave & 3, et0 = (wave >> 2) * 4, mt0 = (wave >> 2) * 2;
    u32x4 rzb[2], rg[2], rs1[4];
    const bf16_t* zb_ = Z + ((size_t)h * MROWS + row0) * 640;
    tile_load(rzb, zb_ + 256, 640, tid); tile_load(rg, zb_ + 512, 640, tid);
    {
        const int cc0 = (nc < 128) ? 4 + nc : (nc - 128), cc1 = (nc < 128) ? 4 + (127 - nc) : 3 - (nc - 128);
        const bf16_t* S0 = SB + (size_t)(((0 * 4 + b) * 4 + h) * NCHUNK + cc0) * 16384; const bf16_t* S1 = SB + (size_t)(((1 * 4 + b) * 4 + h) * NCHUNK + cc1) * 16384;
#pragma unroll
        for (int k = 0; k < 4; ++k) rs1[k] = *(const u32x4*)(S1 + (tid + 512 * k) * 8);
        (void)S0;
    }
    const float lb0 = lb_of(hg_lower, 0, ch), lb1 = lb_of(hg_lower, 1, ch);
    tile_to_lds(rq, RQ, tid); tile_to_lds(rzf, RZ, tid); tile_to_lds(rv, RV, tid);
    __syncthreads();
    if (next_task >= 0) hgrn_c_load(next_task, Z, rq, rzf, rv, tid);
    float qv[16];
    {
        unsigned w[8];
#pragma unroll
        for (int i2 = 0; i2 < 8; ++i2) w[i2] = (unsigned)RV[(seg * 16 + 2 * i2) * 128 + d] | ((unsigned)RV[(seg * 16 + 2 * i2 + 1) * 128 + d] << 16);
        *(u32x4*)(VT + d * 72 + seg * 16) = (u32x4){w[0], w[1], w[2], w[3]}; *(u32x4*)(VT + d * 72 + seg * 16 + 8) = (u32x4){w[4], w[5], w[6], w[7]};
#pragma unroll
        for (int ii = 0; ii < 16; ++ii) { const float q = bf2f(RQ[(seg * 16 + ii) * 128 + d]); qv[ii] = q * __builtin_amdgcn_rcpf(1.0f + __expf(-q)); }
    }
    f32x4 oacc[4];
#pragma unroll
    for (int j = 0; j < 4; ++j) oacc[j] = (f32x4){0.f, 0.f, 0.f, 0.f};
#pragma unroll
    for (int dir = 0; dir < 2; ++dir) {
        Gate gg;
        gate_math(gg, dir ? RQ : RZ, dir ? lb1 : lb0, d, seg);
        TOT[seg * 128 + d] = gg.run;
        __syncthreads();
        if (dir == 0) tile_to_lds(rzb, RQ, tid);
#pragma unroll
        for (int k = 0; k < 4; ++k) { const int idx = tid + 512 * k; *(u32x4*)(SL + (idx >> 4) * 136 + (idx & 15) * 8) = dir ? rs1[k] : rs0[k]; }
        if (dir == 0 && next_task >= 0) hgrn_c_load_s0(next_task, SB, rs0, tid);
        float offp = 1.f, offs = 1.f;
#pragma unroll
        for (int s = 0; s < 4; ++s) { const float tv = TOT[s * 128 + d]; if (s < seg) offp *= tv; if (s > seg) offs *= tv; }
        if (dir == 0) { float acc = offp;
#pragma unroll
            for (int ii = 0; ii < 16; ++ii) { acc *= gg.f[ii];
                QH[(seg * 16 + ii) * 136 + d] = (bf16_t)f2bf(qv[ii] * acc); KH[(seg * 16 + ii) * 136 + d] = (bf16_t)f2bf(gg.kv[ii] * __builtin_amdgcn_rcpf(acc)); } }
        else { float acc = offs;
#pragma unroll
            for (int ii = 15; ii >= 0; --ii) { acc *= gg.f[ii];
                QH[(seg * 16 + ii) * 136 + d] = (bf16_t)f2bf(qv[ii] * acc); KH[(seg * 16 + ii) * 136 + d] = (bf16_t)f2bf(gg.kv[ii] * __builtin_amdgcn_rcpf(acc)); } }
        __syncthreads();
        bf16x8 aq[4];
#pragma unroll
        for (int ks = 0; ks < 4; ++ks) aq[ks] = *(const bf16x8*)(QH + (it * 16 + fr) * 136 + ks * 32 + fq * 8);
#pragma unroll
        for (int mm = 0; mm < 2; ++mm) { const int mt = mt0 + mm; f32x4 acc = {0.f, 0.f, 0.f, 0.f};
#pragma unroll
            for (int ks = 0; ks < 4; ++ks) { const bf16x8 bk = *(const bf16x8*)(KH + (mt * 16 + fr) * 136 + ks * 32 + fq * 8); acc = __builtin_amdgcn_mfma_f32_16x16x32_bf16(aq[ks], bk, acc, 0, 0, 0); }
            const int m = mt * 16 + fr;
#pragma unroll
            for (int r = 0; r < 4; ++r) { const int n = it * 16 + fq * 4 + r; const bool keep = dir ? (m >= n) : (m <= n); P[n * 72 + m] = (bf16_t)(cvtpk(keep ? acc[r] : 0.f, 0.f) & 0xffffu); } }
        __syncthreads();
        bf16x8 ap[2];
#pragma unroll
        for (int ks = 0; ks < 2; ++ks) ap[ks] = *(const bf16x8*)(P + (it * 16 + fr) * 72 + ks * 32 + fq * 8);
#pragma unroll
        for (int j = 0; j < 4; ++j) { const int et = et0 + j;
#pragma unroll
            for (int ks = 0; ks < 2; ++ks) { const bf16x8 bv = *(const bf16x8*)(VT + (et * 16 + fr) * 72 + ks * 32 + fq * 8); oacc[j] = __builtin_amdgcn_mfma_f32_16x16x32_bf16(ap[ks], bv, oacc[j], 0, 0, 0); }
#pragma unroll
            for (int ks = 0; ks < 4; ++ks) { const bf16x8 bs = *(const bf16x8*)(SL + (et * 16 + fr) * 136 + ks * 32 + fq * 8); oacc[j] = __builtin_amdgcn_mfma_f32_16x16x32_bf16(aq[ks], bs, oacc[j], 0, 0, 0); } }
        __syncthreads();
    }
#pragma unroll
    for (int j = 0; j < 4; ++j)
#pragma unroll
        for (int r = 0; r < 4; ++r) OS[(it * 16 + fq * 4 + r) * 132 + (et0 + j) * 16 + fr] = oacc[j][r];
    __syncthreads();
#pragma unroll
    for (int k = 0; k < 2; ++k) {
        const int idx = tid + 512 * k, n = idx >> 4, e0 = (idx & 15) * 8; const float* op = OS + n * 132 + e0; float o[8]; float ss = 0.f;
#pragma unroll
        for (int e = 0; e < 8; ++e) { o[e] = op[e]; ss += o[e] * o[e]; }
        ss = row16_sum(ss);
        const float rstd = rsqrtf(ss * (1.f / 128.f) + EPS);
        const unsigned gw_[4] = {rg[k].x, rg[k].y, rg[k].z, rg[k].w}; unsigned ow[4];
#pragma unroll
        for (int e2 = 0; e2 < 4; ++e2) { const float ga = __uint_as_float(gw_[e2] << 16), gb = __uint_as_float(gw_[e2] & 0xffff0000u);
            const float va = o[2 * e2] * rstd * onorm_g[e0 + 2 * e2] * (ga * __builtin_amdgcn_rcpf(1.0f + __expf(-ga))), vb = o[2 * e2 + 1] * rstd * onorm_g[e0 + 2 * e2 + 1] * (gb * __builtin_amdgcn_rcpf(1.0f + __expf(-gb)));
            ow[e2] = cvtpk(va, vb); }
        *(u32x4*)(MIX + (size_t)(row0 + n) * DM + 512 + h * 128 + e0) = (u32x4){ow[0], ow[1], ow[2], ow[3]};
    }
    __syncthreads();
}

struct QKRow { u32x2 a[3][2]; };
__device__ __forceinline__ void qk_load4(QKRow (&R)[4], int row0, const bf16_t* Z1, int loff) {
#pragma unroll
    for (int r4 = 0; r4 < 4; ++r4) { const bf16_t* zp = Z1 + (size_t)(row0 + r4) * ATTIN + loff;
#pragma unroll
        for (int ps = 0; ps < 3; ++ps) { R[r4].a[ps][0] = *(const u32x2*)(zp + ps * 512); R[r4].a[ps][1] = *(const u32x2*)(zp + ps * 512 + 32); } }
}
__device__ __forceinline__ void qk_finish4(const QKRow (&R)[4], int row0, int g, int half, int doff, const float (&inv4)[4], const float (&gq)[8], const float (&gk)[8], bf16_t* Qc, bf16_t* Kc, bf16_t* Vc) {
#pragma unroll
    for (int r4 = 0; r4 < 4; ++r4) { const int row = row0 + r4; const int b = row / ROWS_B, p = row - b * ROWS_B; const bool isctx = p >= SEQL;
        float sn[4], cs[4];
#pragma unroll
        for (int t = 0; t < 4; ++t) { sn[t] = 0.f; cs[t] = 1.f; }
        if (!isctx) { const float pos = (float)(half ? (p & 63) : (p >> 6));
#pragma unroll
            for (int t = 0; t < 4; ++t) { float rev = pos * inv4[t]; rev -= rintf(rev); sn[t] = __builtin_amdgcn_sinf(rev); cs[t] = __builtin_amdgcn_cosf(rev); } }
#pragma unroll
        for (int ps = 0; ps < 3; ++ps) {
            if (ps < 2 && isctx) continue;
            const u32x2 w1 = R[r4].a[ps][0], w2 = R[r4].a[ps][1];
            float x1[4] = {__uint_as_float(w1.x << 16), __uint_as_float(w1.x & 0xffff0000u), __uint_as_float(w1.y << 16), __uint_as_float(w1.y & 0xffff0000u)};
            float x2[4] = {__uint_as_float(w2.x << 16), __uint_as_float(w2.x & 0xffff0000u), __uint_as_float(w2.y << 16), __uint_as_float(w2.y & 0xffff0000u)};
            float ss = (x1[0] * x1[0] + x1[1] * x1[1]) + (x1[2] * x1[2] + x1[3] * x1[3]) + (x2[0] * x2[0] + x2[1] * x2[1]) + (x2[2] * x2[2] + x2[3] * x2[3]);
            ss = row16_sum(ss);
            const float rstd = rsqrtf(ss * (1.f / 128.f) + EPS);
            u32x2 o1, o2;
            { float y1[4], y2[4];
#pragma unroll
              for (int t = 0; t < 4; ++t) { const float a1 = x1[t] * rstd * (ps < 2 ? gq[t] : gk[t]), a2 = x2[t] * rstd * (ps < 2 ? gq[4 + t] : gk[4 + t]);
                  y1[t] = a1 * cs[t] - a2 * sn[t]; y2[t] = a2 * cs[t] + a1 * sn[t]; }
              o1.x = pk2(y1[0], y1[1]); o1.y = pk2(y1[2], y1[3]); o2.x = pk2(y2[0], y2[1]); o2.y = pk2(y2[2], y2[3]); }
            bf16_t* dst;
            if (ps < 2) dst = Qc + ((size_t)(b * 8 + ps * 4 + g) * SEQL + p) * 128;
            else if (g < 2) dst = Kc + ((size_t)(b * 2 + g) * ROWS_B + p) * 128;
            else { dst = Vc + ((size_t)(b * 2 + (g - 2)) * ROWS_B + p) * 128; o1 = w1; o2 = w2; }
            *(u32x2*)(dst + doff) = o1; *(u32x2*)(dst + doff + 32) = o2;
        }
    }
}
__device__ __forceinline__ void qknorm_rope(int gw, int NGW, int lane, int rmode  , const bf16_t* Z1, const float* qn_g, const float* kn_g, bf16_t* Qc, bf16_t* Kc, bf16_t* Vc) {
    const int g = lane >> 4, sub = lane & 15, half = sub >> 3, i0 = (sub & 7) * 4, doff = half * 64 + i0, loff = g * 128 + doff;
    float inv4[4], gq[8], gk[8];
#pragma unroll
    for (int t = 0; t < 4; ++t) { inv4[t] = exp2f(-(float)(i0 + t) * (13.287712379549449f / 32.f)) * 0.15915494309189535f;
        gq[t] = qn_g[doff + t]; gq[4 + t] = qn_g[doff + 32 + t]; gk[t] = kn_g[doff + t]; gk[4 + t] = kn_g[doff + 32 + t]; }
#define QK_ON(r0) ((((r0) % ROWS_B) >= SEQL) == (rmode == 2))
    int row0 = gw * 4; const int step = NGW * 4;
    if (row0 >= MROWS) return;
    QKRow A[4], B[4];
    if (QK_ON(row0)) qk_load4(A, row0, Z1, loff);
    for (;;) {
        int n0 = row0 + step; bool more = n0 < MROWS;
        if (more && QK_ON(n0)) qk_load4(B, n0, Z1, loff);
        if (QK_ON(row0)) qk_finish4(A, row0, g, half, doff, inv4, gq, gk, Qc, Kc, Vc);
        if (!more) break;
        row0 = n0; n0 = row0 + step; more = n0 < MROWS;
        if (more && QK_ON(n0)) qk_load4(A, n0, Z1, loff);
        if (QK_ON(row0)) qk_finish4(B, row0, g, half, doff, inv4, gq, gk, Qc, Kc, Vc);
        if (!more) break;
        row0 = n0;
    }
#undef QK_ON
}
}
#define LAS __attribute__((address_space(3)))
#define XB_TMO      128
#define XB_XCNT(j)  (256  + 64 * (j))
#define XB_XSUB(j)  (1280 + 64 * (j))
#define XB_XGEN(j)  (2304 + 64 * (j))
#define XB_TOP      3328
#define XB_TOPGEN   3392
#define XCD_BAR_WORDS 3456
#define XB_SPIN_CAP (1u << 18)

__device__ __forceinline__ unsigned xb_ld(unsigned* p)              { return __hip_atomic_load(p, __ATOMIC_RELAXED, __HIP_MEMORY_SCOPE_AGENT); }
__device__ __forceinline__ unsigned xb_add(unsigned* p, unsigned v) { return __hip_atomic_fetch_add(p, v, __ATOMIC_RELAXED, __HIP_MEMORY_SCOPE_AGENT); }
__device__ __forceinline__ unsigned xb_xcc_id() { return (unsigned)__builtin_amdgcn_s_getreg((3 << 11) | 20) & 0xFu; }
#define XB_SPIN(cond, bar) do { unsigned _sp = 0; while (cond) { __builtin_amdgcn_s_sleep(1); \
    if ((++_sp & 255u) == 0u) { if (xb_ld(&(bar)[XB_TMO])) break; if (_sp > XB_SPIN_CAP) { atomicAdd(&(bar)[XB_TMO], 1u); break; } } } } while (0)

struct XcdBarrier {
    unsigned* bar; unsigned x;
    volatile LAS unsigned* st;
};

__device__ __forceinline__ XcdBarrier xcd_barrier_post(unsigned* bar, volatile LAS unsigned* st) {
    XcdBarrier b; b.bar = bar; b.x = xb_xcc_id(); b.st = st;
    if (threadIdx.x == 0) (void)xb_add(&bar[XB_XCNT(b.x)], 1u);
    return b;
}
__device__ __forceinline__ void xcd_barrier_complete(unsigned* bar, unsigned x, unsigned& nloc, unsigned& nx) {
    const unsigned G = gridDim.x * gridDim.y * gridDim.z;
    unsigned sum, cnt, mine, sp = 0u;
    for (;;) {
        sum = 0u; cnt = 0u; mine = 0u;
#pragma unroll
        for (unsigned j = 0; j < 16; ++j) { const unsigned c = xb_ld(&bar[XB_XCNT(j)]); sum += c; cnt += (c > 0u) ? 1u : 0u; mine = (j == x) ? c : mine; }
        if (sum == G) break;
        __builtin_amdgcn_s_sleep(1);
        if ((++sp & 255u) == 0u) { if (xb_ld(&bar[XB_TMO])) break; if (sp > XB_SPIN_CAP) { atomicAdd(&bar[XB_TMO], 1u); break; } }
    }
    nloc = mine > 0u ? mine : 1u; nx = cnt > 0u ? cnt : 1u;
}

__device__ __forceinline__ void xcd_barrier(const XcdBarrier& b) {
    asm volatile("s_waitcnt vmcnt(0)" ::: "memory");
    __syncthreads();
    if (threadIdx.x == 0) {
        unsigned* bar = b.bar;
        __builtin_amdgcn_s_waitcnt(0);
        unsigned nloc = b.st[0], nx = b.st[1];
        if (nloc == 0u) { xcd_barrier_complete(bar, b.x, nloc, nx); b.st[0] = nloc; b.st[1] = nx; }
        const unsigned old = xb_add(&bar[XB_XSUB(b.x)], 1u);
        const unsigned gen = old / nloc;
        if (old + 1u == (gen + 1u) * nloc) {
            __builtin_amdgcn_fence(__ATOMIC_RELEASE, "agent");
            asm volatile("s_waitcnt vmcnt(0)" ::: "memory");
            const unsigned og = xb_add(&bar[XB_TOP], 1u);
            const unsigned tg = og / nx;
            if (og + 1u == (tg + 1u) * nx) xb_add(&bar[XB_TOPGEN], 1u);
            else XB_SPIN(xb_ld(&bar[XB_TOPGEN]) == tg, bar);
            __builtin_amdgcn_fence(__ATOMIC_ACQUIRE, "agent");
            xb_add(&bar[XB_XGEN(b.x)], 1u);
            asm volatile("s_waitcnt vmcnt(0)" ::: "memory");
        } else {
            XB_SPIN(xb_ld(&bar[XB_XGEN(b.x)]) == gen, bar);
            __builtin_amdgcn_fence(__ATOMIC_ACQUIRE, "agent");
            asm volatile("s_waitcnt vmcnt(0)" ::: "memory");
        }
    }
    __syncthreads();
}


#ifndef MK_N_LAUNCHES
#define MK_N_LAUNCHES 1
#endif
struct Args { const float* in[19]; float* out; unsigned char* ws; int ph_lo, ph_hi; };

__global__ void __launch_bounds__(mk::NTHR, 2) fwd_kernel(Args args) {
    using namespace mk;
    extern __shared__ __attribute__((aligned(16))) unsigned char lds[];
    cg::grid_group grid = cg::this_grid();
    const int tid = threadIdx.x, lane = tid & 63, wave = __builtin_amdgcn_readfirstlane(tid >> 6);
    const int G = gridDim.x, bx = blockIdx.x; const int vcu = (G % 8 == 0) ? (bx % 8) * (G / 8) + bx / 8 : bx;
    const int gw = vcu * NWAVES + wave, NGW = G * NWAVES;
    unsigned char* ws = args.ws;
    const float* x = args.in[0]; const float* cvec = args.in[1]; const float* ctx = args.in[2]; const float* c_ctx = args.in[3];
    const float* ada_w = args.in[4]; const float* ada_b = args.in[5]; const float* norm_g = args.in[6];
    const float* ab_w_in = args.in[7]; const float* ab_w_out = args.in[8]; const float* pool_w = args.in[9]; const float* pool_scale = args.in[10];
    const float* hg_lower = args.in[11]; const float* hg_onorm_g = args.in[12];
    const float* att_w_in = args.in[13]; const float* att_w_out = args.in[14]; const float* qn_g = args.in[15]; const float* kn_g = args.in[16];
    const float* ffn_w_in = args.in[17]; const float* ffn_w_out = args.in[18];
    float* out = args.out;
    float* mods = (float*)(ws + WS_MODS);
    bf16_t* W_ABIN = (bf16_t*)(ws + WS_W_ABIN); bf16_t* W_ABOUT = (bf16_t*)(ws + WS_W_ABOUT); bf16_t* W_ATTIN = (bf16_t*)(ws + WS_W_ATTIN); bf16_t* W_ATTOUT = (bf16_t*)(ws + WS_W_ATTOUT);
    bf16_t* W_FFIN = (bf16_t*)(ws + WS_W_FFIN); bf16_t* W_FFOUT = (bf16_t*)(ws + WS_W_FFOUT); bf16_t* PWT = (bf16_t*)(ws + WS_POOLWT);
    float* DEC = (float*)(ws + WS_DEC); float* CTXS = (float*)(ws + WS_CTXS);
    bf16_t* XN = (bf16_t*)(ws + WS_XN); bf16_t* Y = (bf16_t*)(ws + WS_Y); bf16_t* SB = (bf16_t*)(ws + WS_SB); bf16_t* Z = (bf16_t*)(ws + WS_Z); bf16_t* MIX = (bf16_t*)(ws + WS_MIX);
    bf16_t* H = Z; bf16_t* Z1 = Z; bf16_t* UU = Z; bf16_t* ZH = Z + (size_t)MROWS * 512; bf16_t* Qc = (bf16_t*)(ws + WS_QC); bf16_t* Kc = (bf16_t*)(ws + WS_KC); bf16_t* Vc = (bf16_t*)(ws + WS_VC);
    PG8_LAS unsigned char* ldsl = (PG8_LAS unsigned char*)lds;
    const int lo = args.ph_lo, hi = args.ph_hi;
    volatile LAS unsigned* bst = (volatile LAS unsigned*)((LAS unsigned char*)lds + (LDS_BYTES - 64));
    if (tid < 2) bst[tid] = 0u;
    __syncthreads();
    XcdBarrier xbar = xcd_barrier_post((unsigned*)(ws + WS_CTL) + 4096, bst);
#define IN(k) (lo <= (k) && (k) < hi)
#define SEAM(k) do { if (IN(k) && IN((k) + 1)) { if (hi < 0) { asm volatile("s_waitcnt vmcnt(0)" ::: "memory"); grid.sync(); } else xcd_barrier(xbar); } } while (0)

    if (IN(0)) {
        float* scr = (float*)(lds + wave * 16384);
        constexpr int I_ADA = 2 * 96 * 16;
        constexpr int I1 = 16 * 96, I2 = 16 * 32, I3 = 16 * 48, I4 = 16 * 32, I5 = 16 * 176, I6 = 44 * 32, I7 = 8;
        constexpr int NIT = I_ADA + I1 + I2 + I3 + I4 + 2 * I5 + 2 * I6 + 4 * I7;
        for (int it = gw; it < NIT; it += NGW) {
            int r = it;
            if (r < I_ADA) { ada_item(r, cvec, c_ctx, ada_w, ada_b, mods, lane); continue; } r -= I_ADA;
            if (r < I1) { transpose_abin(ab_w_in, W_ABIN, r, scr, lane); continue; } r -= I1;
            if (r < I2) { transpose_plain(ab_w_out, DM, DM, W_ABOUT, r, scr, lane); continue; } r -= I2;
            if (r < I3) { transpose_plain(att_w_in, DM, ATTIN, W_ATTIN, r, scr, lane); continue; } r -= I3;
            if (r < I4) { transpose_plain(att_w_out, DM, DM, W_ATTOUT, r, scr, lane); continue; } r -= I4;
            if (r < 2 * I5) { const int l = r / I5; transpose_ffin(ffn_w_in + (size_t)l * DM * FFIN, W_FFIN + (size_t)l * FFIN * DM, r - l * I5, scr, lane); continue; } r -= 2 * I5;
            if (r < 2 * I6) { const int l = r / I6; transpose_plain(ffn_w_out + (size_t)l * FFH * DM, FFH, DM, W_FFOUT + (size_t)l * DM * FFH, r - l * I6, scr, lane); continue; } r -= 2 * I6;
            { const int g = r / I7; transpose_plain(pool_w + (size_t)g * 16384, 128, 128, PWT + (size_t)g * 16384, r - g * I7, scr, lane); }
        }
    }
    SEAM(0);
    if (IN(1)) row_phase<false, false, true>(gw, NGW, lane, tid, (float*)lds, 0, x, ctx, nullptr, nullptr, nullptr, nullptr, 0, nullptr, norm_g + 0 * DM, mods, 0, 1, XN);
    SEAM(1);
    if (IN(2)) { pg8::Gemm g{XN, W_ABIN, MROWS, ABIN, DM}; pg8::StaticOrder S; S.init(MROWS, ABIN, G, bx); pg8::EpiZ E{UU, ZH, MROWS};
        pg8::gemm_phase<pg8::EpiZ, pg8::StaticOrder, true, true>(ldsl, g, S, E); }
    SEAM(2);
    if (IN(3)) { u32x4 pzf[2], pzb[2], pv[2]; if (vcu < NTASK_C) hgrn_a_load(vcu, ZH, pzf, pzb, pv, tid);
        for (int t = vcu; t < NTASK_C + NTASK_POOL; t += G) { if (t < NTASK_C) hgrn_a_task(t, (t + G < NTASK_C) ? t + G : -1, pzf, pzb, pv, ZH, hg_lower, SB, DEC, (char*)lds, tid); else pool_task(t - NTASK_C, UU, PWT, pool_scale, MIX, (char*)lds, tid); } }
    SEAM(3);
    if (IN(4)) hgrn_b(vcu, G, tid, SB, DEC);
    SEAM(4);
    if (IN(5)) { u32x4 pq[2], pzf[2], pv[2], ps0[4]; if (vcu < NTASK_C) { hgrn_c_load(vcu, ZH, pq, pzf, pv, tid); hgrn_c_load_s0(vcu, SB, ps0, tid); }
        for (int t = vcu; t < NTASK_C; t += G) hgrn_c_task(t, (t + G < NTASK_C) ? t + G : -1, pq, pzf, pv, ps0, ZH, hg_lower, hg_onorm_g, SB, MIX, (char*)lds, tid); }
    SEAM(5);
    if (IN(6)) { pg8::Gemm g{MIX, W_ABOUT, MROWS, DM, DM}; pg8::LatOrder S; S.init(MLAT, DM, G, bx); pg8::EpiStoreBf16 E{Y, DM};
        pg8::gemm_phase<pg8::EpiStoreBf16, pg8::LatOrder, true, true>(ldsl, g, S, E); }
    SEAM(6);
    if (IN(7)) {
        if (bx < 16) { pg8::Gemm g{MIX, W_ABOUT, MROWS, DM, DM}; pg8::CtxOrder S{bx}; pg8::EpiStoreBf16 E{Y, DM};
            pg8::gemm_phase<pg8::EpiStoreBf16, pg8::CtxOrder, true, true>(ldsl, g, S, E); }
        else row_phase<true, true, true>((bx - 16) * NWAVES + wave, (G - 16) * NWAVES, lane, tid, (float*)lds, 1, x, ctx, out, CTXS, Y, mods, 2, norm_g + 1 * DM, norm_g + 2 * DM, mods, 3, 4, XN);
        xcd_barrier(xbar);
        row_phase<true, true, true>(gw, NGW, lane, tid, (float*)lds, 2, x, ctx, out, CTXS, Y, mods, 2, norm_g + 1 * DM, norm_g + 2 * DM, mods, 3, 4, XN);
    }
    SEAM(7);
    if (IN(8)) { pg8::Gemm g{XN, W_FFIN, MROWS, FFIN, DM}; pg8::StaticOrder S; S.init(MROWS, FFIN, G, bx); pg8::EpiSwiglu E{H, FFH};
        pg8::gemm_phase<pg8::EpiSwiglu, pg8::StaticOrder, true, true>(ldsl, g, S, E); }
    SEAM(8);
    if (IN(9)) { pg8::Gemm g{H, W_FFOUT, MROWS, DM, FFH}; pg8::LatOrder S; S.init(MLAT, DM, G, bx); pg8::EpiStoreBf16 E{Y, DM};
        pg8::gemm_phase<pg8::EpiStoreBf16, pg8::LatOrder, true, true>(ldsl, g, S, E); }
    SEAM(9);
    if (IN(10)) {
        if (bx < 16) { pg8::Gemm g{H, W_FFOUT, MROWS, DM, FFH}; pg8::CtxOrder S{bx}; pg8::EpiStoreBf16 E{Y, DM};
            pg8::gemm_phase<pg8::EpiStoreBf16, pg8::CtxOrder, true, true>(ldsl, g, S, E); }
        else row_phase<true, true, true>((bx - 16) * NWAVES + wave, (G - 16) * NWAVES, lane, tid, (float*)lds, 1, out, CTXS, out, CTXS, Y, mods, 5, norm_g + 3 * DM, norm_g + 4 * DM, mods + 5 * 6144, 0, 1, XN);
        xcd_barrier(xbar);
        row_phase<true, true, true>(gw, NGW, lane, tid, (float*)lds, 2, out, CTXS, out, CTXS, Y, mods, 5, norm_g + 3 * DM, norm_g + 4 * DM, mods + 5 * 6144, 0, 1, XN);
    }
    SEAM(10);
    if (IN(11)) { pg8::Gemm g{XN, W_ATTIN, MROWS, ATTIN, DM}; pg8::LatOrder S; S.init(MLAT, ATTIN, G, bx); pg8::EpiStoreBf16 E{Z1, ATTIN};
        pg8::gemm_phase<pg8::EpiStoreBf16, pg8::LatOrder, true, true>(ldsl, g, S, E); }
    SEAM(11);
    if (IN(12)) {
        if (bx < 8) { pg8::Gemm g{XN, W_ATTIN, MROWS, ATTIN, DM}; pg8::CtxKvOrder S{bx}; pg8::EpiStoreBf16 E{Z1, ATTIN};
            pg8::gemm_phase<pg8::EpiStoreBf16, pg8::CtxKvOrder, true, true>(ldsl, g, S, E); }
        else qknorm_rope((bx - 8) * NWAVES + wave, (G - 8) * NWAVES, lane, 1, Z1, qn_g, kn_g, Qc, Kc, Vc);
        xcd_barrier(xbar);
        qknorm_rope(gw, NGW, lane, 2, Z1, qn_g, kn_g, Qc, Kc, Vc);
    }
    SEAM(12);
    if (IN(13)) {
        for (int u = vcu; u < 1024; u += G) { const int qb = u & 31, gq = (u >> 5) & 3, kvh = (u >> 7) & 1, b = u >> 8, h = kvh * 4 + gq;
            attn::attn_dense_body<attn::bf16>((const attn::bf16*)(Qc + ((size_t)(b * 8 + h) * SEQL + qb * 256) * 128), (const attn::bf16*)(Kc + (size_t)(b * 2 + kvh) * ROWS_B * 128),
                                              (const attn::bf16*)(Vc + (size_t)(b * 2 + kvh) * ROWS_B * 128), MIX + ((size_t)b * ROWS_B + qb * 256) * DM + h * 128, ROWS_B, (char*)lds);
            __syncthreads(); }
    }
    SEAM(13);
    if (IN(14)) { pg8::Gemm g{MIX, W_ATTOUT, MROWS, DM, DM}; pg8::LatOrder S; S.init(MLAT, DM, G, bx); pg8::EpiStoreBf16 E{Y, DM};
        pg8::gemm_phase<pg8::EpiStoreBf16, pg8::LatOrder, true, true>(ldsl, g, S, E); }
    SEAM(14);
    if (IN(15)) row_phase<true, true, true>(gw, NGW, lane, tid, (float*)lds, 1, out, CTXS, out, CTXS, Y, mods + 5 * 6144, 2, norm_g + 5 * DM, norm_g + 6 * DM, mods + 5 * 6144, 3, 4, XN);
    SEAM(15);
    if (IN(16)) { pg8::Gemm g{XN, W_FFIN + (size_t)FFIN * DM, MROWS, FFIN, DM}; pg8::LatOrder S; S.init(MLAT, FFIN, G, bx); pg8::EpiSwiglu E{H, FFH};
        pg8::gemm_phase<pg8::EpiSwiglu, pg8::LatOrder, true, true>(ldsl, g, S, E); }
    SEAM(16);
    if (IN(17)) { pg8::Gemm g{H, W_FFOUT + (size_t)DM * FFH, MROWS, DM, FFH}; pg8::LatOrder S; S.init(MLAT, DM, G, bx); pg8::EpiStoreBf16 E{Y, DM};
        pg8::gemm_phase<pg8::EpiStoreBf16, pg8::LatOrder, true, true>(ldsl, g, S, E); }
    SEAM(17);
    if (IN(18)) row_phase<true, true, false>(gw, NGW, lane, tid, (float*)lds, 1, out, CTXS, out, CTXS, Y, mods + 5 * 6144, 5, norm_g + 7 * DM, nullptr, nullptr, 0, 0, nullptr);
#undef IN
#undef SEAM
}

extern "C" void kernel_launch(void* const* d_in, const int* in_sizes, int n_in, void* d_out, int out_size, void* d_ws, size_t ws_size, hipStream_t stream) {
    using namespace mk;
    static int grid = 0;
    if (grid == 0) {
        if (n_in != 19 || in_sizes[0] != MLAT * DM || out_size != MLAT * DM || ws_size < WS_END) { fprintf(stderr, "kernel_launch: unexpected shapes (n_in %d, in0 %d, out %d, ws %zu)\n", n_in, n_in > 0 ? in_sizes[0] : -1, out_size, ws_size); grid = -1; return; }
        int dev = 0, cus = 0, per_cu = 0;
        if (hipGetDevice(&dev) != hipSuccess || hipDeviceGetAttribute(&cus, hipDeviceAttributeMultiprocessorCount, dev) != hipSuccess) { grid = -1; return; }
        if (hipFuncSetAttribute((const void*)fwd_kernel, hipFuncAttributeMaxDynamicSharedMemorySize, LDS_BYTES) != hipSuccess) { fprintf(stderr, "kernel_launch: hipFuncSetAttribute failed\n"); grid = -1; return; }
        if (hipOccupancyMaxActiveBlocksPerMultiprocessor(&per_cu, (const void*)fwd_kernel, NTHR, LDS_BYTES) != hipSuccess || per_cu < 1) { fprintf(stderr, "kernel_launch: occupancy query says %d\n", per_cu); per_cu = 1; }
        (void)hipGetLastError();
        grid = cus;
    }
    if (grid < 0) return;
    (void)hipMemsetAsync((char*)d_ws + WS_CTL, 0, CTL_ZERO_BYTES, stream);
    Args a{};
    for (int i = 0; i < 19; ++i) a.in[i] = (const float*)d_in[i];
    a.out = (float*)d_out; a.ws = (unsigned char*)d_ws;
#if MK_N_LAUNCHES == 1
    a.ph_lo = 0; a.ph_hi = N_PHASES;
    void* kargs[] = {&a};
    hipError_t e = hipLaunchCooperativeKernel((const void*)fwd_kernel, dim3(grid), dim3(NTHR), kargs, LDS_BYTES, stream);
    if (e != hipSuccess) fprintf(stderr, "kernel_launch: cooperative launch failed: %s (grid %d)\n", hipGetErrorString(e), grid);
#else
    for (int ph = 0; ph < N_PHASES; ++ph) { a.ph_lo = ph; a.ph_hi = ph + 1; hipLaunchKernelGGL(fwd_kernel, dim3(grid), dim3(NTHR), LDS_BYTES, stream, a); }
#endif
}
```
